# Optimizing an MI355X kernel written in HIP

```python
import math
import jax
import jax.numpy as jnp
from jax import lax
import numpy as np

D_MODEL = 2048
BATCH = 4
SEQ = 2048
DEPTH = 4
DEC_BATCH = 128
DEC_SEQ = 8
PAST_LEN = 16384
PAGE_SIZE = 128

LRU_WIDTH = D_MODEL // 2
LRU_BLOCKS = 16
LRU_BLOCK = LRU_WIDTH // LRU_BLOCKS
LRU_C = 8.0
CONV_WIDTH = 4
DN_HEAD_DIM = 128
DN_HEADS = (D_MODEL // 2) // DN_HEAD_DIM
DN_DK = DN_HEAD_DIM
DN_DV = DN_HEAD_DIM
DN_QK = DN_HEADS * DN_DK
DN_VW = DN_HEADS * DN_DV
DN_CHUNK = 64
POOL_WIDTH = D_MODEL // 2
POOL_WINDOWS = (2, 4, 8, 16)
POOL_GROUPS = 4
POOL_GROUP = POOL_WIDTH // POOL_GROUPS
POOL_BUF = 15
D_FF = 4 * D_MODEL
EPS = 1e-6
IN_SPLITS = (LRU_WIDTH, LRU_WIDTH, DN_QK, DN_QK, DN_VW, DN_VW, DN_HEADS, DN_HEADS, POOL_WIDTH, D_MODEL, D_MODEL, D_MODEL)
D_IN = sum(IN_SPLITS)

kernel_name = 'hybrid_rglru_deltanet_pool_step'


def rmsnorm(x, gain):
    xf = x.astype(jnp.float32)
    y = xf * lax.rsqrt(jnp.mean(xf * xf, axis=-1, keepdims=True) + EPS)
    return (y * gain.astype(jnp.float32)).astype(x.dtype)


def split_cols(p):
    outs = []
    start = 0
    for w in IN_SPLITS:
        outs.append(p[..., start:start + w])
        start += w
    return outs


def causal_dwconv(x, buf, w, b=None):
    full = jnp.concatenate([buf.astype(x.dtype), x], axis=1)
    T = x.shape[1]
    y = sum(full[:, j:j + T] * w[j].astype(x.dtype) for j in range(CONV_WIDTH))
    if b is not None:
        y = y + b.astype(x.dtype)
    return y, full[:, T:]


def _lin_combine(c1, c2):
    a1, b1 = c1
    a2, b2 = c2
    return a1 * a2, a2 * b1 + b2


def rg_lru(x, w_a, b_a, w_x, b_x, lam, h0):
    B, T, _ = x.shape
    f32 = jnp.float32
    xf = x.astype(f32)
    xb = xf.reshape(B, T, LRU_BLOCKS, LRU_BLOCK)
    r = jax.nn.sigmoid(jnp.einsum('btnc,ncd->btnd', xb, w_a.astype(f32)).reshape(B, T, LRU_WIDTH) + b_a.astype(f32))
    i = jax.nn.sigmoid(jnp.einsum('btnc,ncd->btnd', xb, w_x.astype(f32)).reshape(B, T, LRU_WIDTH) + b_x.astype(f32))
    log_a = -LRU_C * r * jax.nn.softplus(-lam.astype(f32))
    a = jnp.exp(log_a)
    bterm = jnp.sqrt(-jnp.expm1(2.0 * log_a)) * (i * xf)
    bterm = bterm.at[:, 0].add(a[:, 0] * h0.astype(f32))
    _, h = lax.associative_scan(_lin_combine, (a, bterm), axis=1)
    return h, h[:, -1]


def l2norm(x):
    return x * lax.rsqrt(jnp.sum(x * x, axis=-1, keepdims=True) + EPS)


def gated_delta_rule(q, k, v, beta, g, s0):
    B, T, H, DK = q.shape
    DV = v.shape[-1]
    C = DN_CHUNK if T >= DN_CHUNK else T
    n = -(-T // C)
    pad = n * C - T

    def prep(a):
        a = jnp.pad(a, [(0, 0), (0, pad)] + [(0, 0)] * (a.ndim - 2))
        a = a.reshape((B, n, C) + a.shape[2:])
        return jnp.moveaxis(a, (1, 3), (0, 2))

    q, k, v, beta, g = prep(q), prep(k), prep(v), prep(beta), prep(g)
    gamma = jnp.cumsum(g, axis=-1)
    incl = jnp.tril(jnp.ones((C, C), dtype=bool))
    strict = jnp.tril(jnp.ones((C, C), dtype=bool), k=-1)
    decay = jnp.exp(jnp.where(incl, gamma[..., :, None] - gamma[..., None, :], -jnp.inf))
    kk = jnp.einsum('nbhik,nbhjk->nbhij', k, k)
    a_mat = jnp.eye(C, dtype=jnp.float32) + jnp.where(strict, beta[..., None] * decay * kk, 0.0)
    eg = jnp.exp(gamma)
    rhs = jnp.concatenate([beta[..., None] * v, (beta * eg)[..., None] * k], axis=-1)
    sol = lax.linalg.triangular_solve(a_mat, rhs, left_side=True, lower=True, unit_diagonal=True)
    u_c, wk_c = sol[..., :DV], sol[..., DV:]
    qk = jnp.einsum('nbhik,nbhjk->nbhij', q, k) * decay
    qg = q * eg[..., None]
    kd = k * jnp.exp(gamma[..., -1:] - gamma)[..., None]
    g_last = jnp.exp(gamma[..., -1])

    def step(s, inp):
        qg_c, kd_c, uc, wkc, qk_c, gl_c = inp
        w = uc - jnp.einsum('bhck,bhkv->bhcv', wkc, s)
        o = jnp.einsum('bhck,bhkv->bhcv', qg_c, s) + jnp.einsum('bhij,bhjv->bhiv', qk_c, w)
        s = gl_c[..., None, None] * s + jnp.einsum('bhck,bhcv->bhkv', kd_c, w)
        return s, o

    s_last, o = lax.scan(step, s0, (qg, kd, u_c, wk_c, qk, g_last))
    o = jnp.moveaxis(o, (0, 2), (1, 3)).reshape(B, n * C, H, DV)[:, :T]
    return o, s_last


def multiscale_pool(u, buf, past_len, w_pool, scale):
    B, T, _ = u.shape
    f32 = jnp.float32
    P = POOL_BUF
    full = jnp.concatenate([buf.astype(f32), u.astype(f32)], axis=1)
    cs = jnp.concatenate([jnp.zeros((B, 1, POOL_WIDTH), f32), jnp.cumsum(full, axis=1)], axis=1)
    pos = jnp.arange(T) + 1 + past_len
    means = []
    for gi, w in enumerate(POOL_WINDOWS):
        c0 = gi * POOL_GROUP
        c1 = c0 + POOL_GROUP
        s = cs[:, P + 1:P + 1 + T, c0:c1] - cs[:, P + 1 - w:P + 1 - w + T, c0:c1]
        cnt = jnp.minimum(pos, w).astype(f32)
        means.append(s / cnt[None, :, None])
    pooled = jnp.concatenate(means, axis=-1)
    d = (pooled - full[:, P:]).reshape(B, T, POOL_GROUPS, POOL_GROUP)
    y = jnp.einsum('btgc,gcd->btgd', d, w_pool.astype(f32)).reshape(B, T, POOL_WIDTH) * scale.astype(f32)
    return y.astype(u.dtype), full[:, T:].astype(u.dtype)


def layer(x, past_len, h0, lru_buf, s0, dn_buf, pool_buf,
          norm_mix, w_in, lru_conv_w, lru_conv_b, lru_gate_a_w, lru_gate_a_b, lru_gate_x_w, lru_gate_x_b,
          lru_lambda, dn_conv_w, dn_a_log, dn_dt_bias, dn_norm_w, pool_w, pool_scale,
          w_br_lru, w_br_dn, w_br_pool, w_out, norm_mlp, w_up, w_down):
    B, T, _ = x.shape
    f32 = jnp.float32
    xn = rmsnorm(x, norm_mix)
    xl, gl, q, k, v, z, b_raw, a_raw, u_pool, g_lru, g_dn, g_pool = split_cols(xn @ w_in)

    xl, new_lru_buf = causal_dwconv(xl, lru_buf, lru_conv_w, lru_conv_b)
    h, h_last = rg_lru(xl, lru_gate_a_w, lru_gate_a_b, lru_gate_x_w, lru_gate_x_b, lru_lambda, h0)
    o_lru = (h * jax.nn.gelu(gl.astype(f32))).astype(x.dtype)

    qkv, new_dn_buf = causal_dwconv(jnp.concatenate([q, k, v], axis=-1), dn_buf, dn_conv_w)
    qkv = jax.nn.silu(qkv.astype(f32))
    qh = l2norm(qkv[..., :DN_QK].reshape(B, T, DN_HEADS, DN_DK)) * (DN_DK ** -0.5)
    kh = l2norm(qkv[..., DN_QK:2 * DN_QK].reshape(B, T, DN_HEADS, DN_DK))
    vh = qkv[..., 2 * DN_QK:].reshape(B, T, DN_HEADS, DN_DV)
    beta = jax.nn.sigmoid(b_raw.astype(f32))
    g = -jnp.exp(dn_a_log.astype(f32)) * jax.nn.softplus(a_raw.astype(f32) + dn_dt_bias.astype(f32))
    o, s_last = gated_delta_rule(qh, kh, vh, beta, g, s0.astype(f32))
    o = o * lax.rsqrt(jnp.mean(o * o, axis=-1, keepdims=True) + EPS) * dn_norm_w.astype(f32)
    o = o * jax.nn.silu(z.astype(f32).reshape(B, T, DN_HEADS, DN_DV))
    o_dn = o.reshape(B, T, DN_VW).astype(x.dtype)

    o_pool, new_pool_buf = multiscale_pool(u_pool, pool_buf, past_len, pool_w, pool_scale)

    merged = (jax.nn.sigmoid(g_lru) * (o_lru @ w_br_lru)
              + jax.nn.sigmoid(g_dn) * (o_dn @ w_br_dn)
              + jax.nn.sigmoid(g_pool) * (o_pool @ w_br_pool))
    x = x + merged @ w_out

    hm = jnp.square(jax.nn.relu(rmsnorm(x, norm_mlp) @ w_up))
    x = x + hm @ w_down
    return x, (h_last, new_lru_buf, s_last, new_dn_buf, new_pool_buf)


def setup_inputs(seed: int = 0) -> dict:
    key = jax.random.key(seed)
    ks = iter(jax.random.split(key, 40))
    f32 = jnp.float32
    L = DEPTH
    dn_conv_ch = 2 * DN_QK + DN_VW

    def nrm(shape, scale):
        return jax.random.normal(next(ks), shape, f32) * scale

    x_prompt = nrm((BATCH, SEQ, D_MODEL), 1.0)
    x_sample = nrm((DEC_BATCH, DEC_SEQ, D_MODEL), 1.0)
    state_lru_h = nrm((L, DEC_BATCH, LRU_WIDTH), 0.5)
    state_lru_conv = nrm((L, DEC_BATCH, CONV_WIDTH - 1, LRU_WIDTH), 1.0)
    state_dn_s = nrm((L, DEC_BATCH, DN_HEADS, DN_DK, DN_DV), 0.05)
    state_dn_conv = nrm((L, DEC_BATCH, CONV_WIDTH - 1, dn_conv_ch), 1.0)
    state_pool = nrm((L, DEC_BATCH, POOL_BUF, POOL_WIDTH), 1.0)
    norm_mix = 1.0 + nrm((L, D_MODEL), 0.02)
    w_in = nrm((L, D_MODEL, D_IN), D_MODEL ** -0.5)
    lru_conv_w = nrm((L, CONV_WIDTH, LRU_WIDTH), CONV_WIDTH ** -0.5)
    lru_conv_b = nrm((L, LRU_WIDTH), 0.02)
    lru_gate_a_w = nrm((L, LRU_BLOCKS, LRU_BLOCK, LRU_BLOCK), LRU_BLOCK ** -0.5)
    lru_gate_a_b = nrm((L, LRU_WIDTH), 0.02)
    lru_gate_x_w = nrm((L, LRU_BLOCKS, LRU_BLOCK, LRU_BLOCK), LRU_BLOCK ** -0.5)
    lru_gate_x_b = nrm((L, LRU_WIDTH), 0.02)
    a0 = jax.random.uniform(next(ks), (L, LRU_WIDTH), f32, 0.9, 0.999)
    lru_lambda = jnp.log(a0) - jnp.log1p(-a0)
    dn_conv_w = nrm((L, CONV_WIDTH, dn_conv_ch), CONV_WIDTH ** -0.5)
    dn_a_log = jnp.log(jax.random.uniform(next(ks), (L, DN_HEADS), f32, 1.0, 16.0))
    dt = jnp.exp(jax.random.uniform(next(ks), (L, DN_HEADS), f32, math.log(1e-3), math.log(1e-1)))
    dn_dt_bias = dt + jnp.log(-jnp.expm1(-dt))
    dn_norm_w = 1.0 + nrm((L, DN_DV), 0.02)
    pool_w = nrm((L, POOL_GROUPS, POOL_GROUP, POOL_GROUP), POOL_GROUP ** -0.5)
    pool_scale = 1.0 + nrm((L, POOL_WIDTH), 0.02)
    w_br_lru = nrm((L, LRU_WIDTH, D_MODEL), LRU_WIDTH ** -0.5)
    w_br_dn = nrm((L, DN_VW, D_MODEL), DN_VW ** -0.5)
    w_br_pool = nrm((L, POOL_WIDTH, D_MODEL), POOL_WIDTH ** -0.5)
    w_out = nrm((L, D_MODEL, D_MODEL), D_MODEL ** -0.5)
    norm_mlp = 1.0 + nrm((L, D_MODEL), 0.02)
    w_up = nrm((L, D_MODEL, D_FF), D_MODEL ** -0.5)
    w_down = nrm((L, D_FF, D_MODEL), D_FF ** -0.5)
    norm_final = 1.0 + nrm((D_MODEL,), 0.02)
    return {'x_prompt': x_prompt, 'x_sample': x_sample,
            'state_lru_h': state_lru_h, 'state_lru_conv': state_lru_conv, 'state_dn_s': state_dn_s,
            'state_dn_conv': state_dn_conv, 'state_pool': state_pool,
            'norm_mix': norm_mix, 'w_in': w_in, 'lru_conv_w': lru_conv_w, 'lru_conv_b': lru_conv_b,
            'lru_gate_a_w': lru_gate_a_w, 'lru_gate_a_b': lru_gate_a_b, 'lru_gate_x_w': lru_gate_x_w,
            'lru_gate_x_b': lru_gate_x_b, 'lru_lambda': lru_lambda, 'dn_conv_w': dn_conv_w,
            'dn_a_log': dn_a_log, 'dn_dt_bias': dn_dt_bias, 'dn_norm_w': dn_norm_w, 'pool_w': pool_w,
            'pool_scale': pool_scale, 'w_br_lru': w_br_lru, 'w_br_dn': w_br_dn, 'w_br_pool': w_br_pool,
            'w_out': w_out, 'norm_mlp': norm_mlp, 'w_up': w_up, 'w_down': w_down, 'norm_final': norm_final}


def reference(x_prompt, x_sample, state_lru_h, state_lru_conv, state_dn_s, state_dn_conv, state_pool,
              norm_mix, w_in, lru_conv_w, lru_conv_b, lru_gate_a_w, lru_gate_a_b, lru_gate_x_w, lru_gate_x_b,
              lru_lambda, dn_conv_w, dn_a_log, dn_dt_bias, dn_norm_w, pool_w, pool_scale,
              w_br_lru, w_br_dn, w_br_pool, w_out, norm_mlp, w_up, w_down, norm_final):
    f32 = jnp.float32
    bp = x_prompt.shape[0]
    dt = x_prompt.dtype
    p_h0 = jnp.zeros((bp, LRU_WIDTH), f32)
    p_lru_buf = jnp.zeros((bp, CONV_WIDTH - 1, LRU_WIDTH), dt)
    p_s0 = jnp.zeros((bp, DN_HEADS, DN_DK, DN_DV), f32)
    p_dn_buf = jnp.zeros((bp, CONV_WIDTH - 1, 2 * DN_QK + DN_VW), dt)
    p_pool_buf = jnp.zeros((bp, POOL_BUF, POOL_WIDTH), dt)
    xp, xs = x_prompt, x_sample
    p_st, s_st = [], []
    for l in range(DEPTH):
        params = (norm_mix[l], w_in[l], lru_conv_w[l], lru_conv_b[l], lru_gate_a_w[l], lru_gate_a_b[l],
                  lru_gate_x_w[l], lru_gate_x_b[l], lru_lambda[l], dn_conv_w[l], dn_a_log[l], dn_dt_bias[l],
                  dn_norm_w[l], pool_w[l], pool_scale[l], w_br_lru[l], w_br_dn[l], w_br_pool[l], w_out[l],
                  norm_mlp[l], w_up[l], w_down[l])
        xp, st = layer(xp, 0, p_h0, p_lru_buf, p_s0, p_dn_buf, p_pool_buf, *params)
        p_st.append(st)
        xs, st = layer(xs, PAST_LEN, state_lru_h[l], state_lru_conv[l], state_dn_s[l], state_dn_conv[l],
                       state_pool[l], *params)
        s_st.append(st)
    y_prompt = rmsnorm(xp, norm_final)
    y_sample = rmsnorm(xs, norm_final)
    p_lru_h = jnp.stack([s[0] for s in p_st])
    p_lru_conv = jnp.stack([s[1] for s in p_st])
    p_dn_s = jnp.stack([s[2] for s in p_st])
    p_dn_conv = jnp.stack([s[3] for s in p_st])
    p_pool = jnp.stack([s[4] for s in p_st])
    s_lru_h = jnp.stack([s[0] for s in s_st])
    s_lru_conv = jnp.stack([s[1] for s in s_st])
    s_dn_s = jnp.stack([s[2] for s in s_st])
    s_dn_conv = jnp.stack([s[3] for s in s_st])
    s_pool = jnp.stack([s[4] for s in s_st])
    return (y_prompt, y_sample, p_lru_h, p_lru_conv, p_dn_s, p_dn_conv, p_pool,
            s_lru_h, s_lru_conv, s_dn_s, s_dn_conv, s_pool)
```

```cpp
#include <hip/hip_runtime.h>
#include <cstdio>
#include <cstdint>

namespace pg8 {
#define PG8_LAS __attribute__((address_space(3)))
typedef unsigned short bf16_t;
typedef short bf16x8 __attribute__((ext_vector_type(8)));
typedef float f32x4 __attribute__((ext_vector_type(4)));
typedef unsigned u32x4 __attribute__((ext_vector_type(4)));
constexpr int BM = 256, BK = 64, HALF = 128, HTB = HALF * BK * 2  , STAGE_BYTES = 8 * HTB, NXCD = 8, WGM = 8;

__host__ __device__ __forceinline__ int lds_byte(int r, int c) { const int st = (r >> 4) * 2 + (c >> 5), rr = r & 15, cc = c & 31, ob = rr * 64 + cc * 2; return st * 1024 + (ob ^ (((ob >> 9) & 1) << 5)); }
__host__ __device__ __forceinline__ void stage_rc(int b, int& R, int& C) { const int st = b / 1024, sb = b % 1024, swz = sb ^ (((sb >> 9) & 1) << 5); R = (st >> 1) * 16 + swz / 64; C = (st & 1) * 32 + (swz % 64) / 2; }
__host__ __device__ __forceinline__ int perm32(int rho) { const int n = rho >> 4, i = rho & 15; return 8 * (i >> 2) + 4 * n + (i & 3); }

struct Unit { int pm, pn; };
struct Gemm { const bf16_t* A; const bf16_t* Bt; int M, N, K, lda, ldb; };

struct StaticOrder {
    int nM, nN, nwg, G, c;
    __host__ __device__ void init(int M, int N, int G_, int c_) { nM = M / BM; nN = N / BM; nwg = nM * nN; G = G_; c = c_; }
    __host__ __device__ bool next(int i, Unit& u) const {
        if (c < 0) return false;
        const long L = (long)i * G + c; if (L >= nwg) return false;
        int wgid = (int)L; { const int q = nwg / NXCD, r = nwg % NXCD, xcd = wgid % NXCD, off = wgid / NXCD; wgid = (xcd < r ? xcd * (q + 1) : r * (q + 1) + (xcd - r) * q) + off; }
        const int nig = WGM * nN, gid = wgid / nig, fm = gid * WGM, gsz = (nM - fm) < WGM ? (nM - fm) : WGM;
        u.pm = fm + ((wgid % nig) % gsz); u.pn = (wgid % nig) / gsz; return true;
    }
    __device__ __forceinline__ size_t b_extra(const Unit&) const { return 0; }
    __device__ __forceinline__ void a_ready(const Unit&) const {}
    __device__ __forceinline__ void done(const Unit&) const {}
};
struct GroupedOrder : StaticOrder {
    int tpg; size_t bgb;
    __device__ __forceinline__ size_t b_extra(const Unit& u) const { return (size_t)(u.pm / tpg) * bgb; }
};

__device__ __forceinline__ unsigned cvt_pk_bf16(float lo, float hi) { unsigned r; asm volatile("v_cvt_pk_bf16_f32 %0, %1, %2" : "=v"(r) : "v"(lo), "v"(hi)); return r; }

template <class Epi, class Sched, bool ALIGN_EPI = false, bool SP2 = false>
__device__ __forceinline__ void gemm_phase(PG8_LAS unsigned char* lds, const Gemm g, const Sched& S, const Epi& E, const int tid) {
    const int wid = __builtin_amdgcn_readfirstlane(tid >> 6), lane = tid & 63, wr = wid >> 2, wc = wid & 3, fr = lane & 15, fq = lane >> 4;
    const int K = g.K, nt = K / BK;
    unsigned voffA[2], voffB[2];
#pragma unroll
    for (int i = 0; i < 2; ++i) { int R, C; stage_rc(tid * 16 + i * 8192, R, C); const int Rb = Epi::PERM ? ((R & ~31) + perm32(R & 31)) : R;
        voffA[i] = (unsigned)(R * g.lda + C) * 2u; voffB[i] = (unsigned)(Rb * g.ldb + C) * 2u; }
    const size_t kstep = (size_t)(BK * 2);
    const size_t hstepA = (size_t)HALF * g.lda * 2, hstepB = (size_t)HALF * g.ldb * 2;
    const size_t tstepA = 2 * hstepA, tstepB = 2 * hstepB;
    const unsigned ldsw = (unsigned)wid * 1024u;
    const int aoff = lds_byte(wr * 64 + fr, fq * 8), boff = lds_byte(wc * 32 + fr, fq * 8);
#define PG8_SA(b, h) (((b) * 2 + (h)) * HTB)
#define PG8_SB(b, h) ((4 + (b) * 2 + (h)) * HTB)
#define PG8_STAGE(bufoff, gbase, voff) do { _Pragma("unroll") for (int _i = 0; _i < 2; ++_i) \
        __builtin_amdgcn_global_load_lds((const unsigned*)((const char*)(gbase) + (voff)[_i]), (PG8_LAS unsigned*)(lds + (bufoff) + ldsw + _i * 8192), 16, 0, 0); } while (0)
#define PG8_LDA(dst, b, h) do { _Pragma("unroll") for (int m = 0; m < 4; ++m) _Pragma("unroll") for (int k = 0; k < 2; ++k) dst[m][k] = *(const PG8_LAS bf16x8*)(lds + PG8_SA(b, h) + aoff + m * 2048 + k * 1024); } while (0)
#define PG8_LDB(dst, b, h) do { _Pragma("unroll") for (int n = 0; n < 2; ++n) _Pragma("unroll") for (int k = 0; k < 2; ++k) dst[n][k] = *(const PG8_LAS bf16x8*)(lds + PG8_SB(b, h) + boff + n * 2048 + k * 1024); } while (0)
#define PG8_MMA(ai, bj, At, Bt) do { __builtin_amdgcn_s_setprio(1); _Pragma("unroll") for (int m = 0; m < 4; ++m) _Pragma("unroll") for (int n = 0; n < 2; ++n) _Pragma("unroll") for (int k = 0; k < 2; ++k) \
        acc[ai][bj][m][n] = __builtin_amdgcn_mfma_f32_16x16x32_bf16(Bt[n][k], At[m][k], acc[ai][bj][m][n], 0, 0, 0); __builtin_amdgcn_s_setprio(0); } while (0)
#define PG8_WAIT_V(n) asm volatile("s_waitcnt vmcnt(" #n ")" ::: "memory")
#define PG8_WAIT_L(n) asm volatile("s_waitcnt lgkmcnt(" #n ")" ::: "memory")
#define PG8_BAR __builtin_amdgcn_s_barrier()
#define PG8_SCHED __builtin_amdgcn_sched_barrier(0)
    Unit cur, nxt; int ui = 0;
    if (!S.next(0, cur)) return;
    f32x4 acc[2][2][4][2];
#pragma unroll
    for (int a = 0; a < 2; ++a)
#pragma unroll
        for (int b = 0; b < 2; ++b)
#pragma unroll
            for (int m = 0; m < 4; ++m)
#pragma unroll
                for (int n = 0; n < 2; ++n) acc[a][b][m][n] = (f32x4){0.f, 0.f, 0.f, 0.f};
    bf16x8 At[4][2], B0[2][2], B1[2][2];
    const char* cA = (const char*)g.A + (size_t)cur.pm * tstepA; const char* cB = (const char*)g.Bt + (size_t)cur.pn * tstepB + S.b_extra(cur);
    S.a_ready(cur);
    if constexpr (SP2) {
        PG8_STAGE(PG8_SB(0, 0), cB, voffB); PG8_STAGE(PG8_SB(0, 1), cB + hstepB, voffB); PG8_STAGE(PG8_SA(0, 0), cA, voffA); PG8_STAGE(PG8_SA(0, 1), cA + hstepA, voffA);
        if (wr == 1) PG8_BAR;
        PG8_WAIT_V(2); PG8_BAR;
        PG8_STAGE(PG8_SB(1, 0), cB + kstep, voffB); PG8_STAGE(PG8_SA(1, 0), cA + kstep, voffA); PG8_STAGE(PG8_SB(1, 1), cB + hstepB + kstep, voffB);
        PG8_WAIT_V(6); PG8_BAR;
    } else {
        PG8_STAGE(PG8_SB(0, 0), cB, voffB); PG8_STAGE(PG8_SA(0, 0), cA, voffA); PG8_STAGE(PG8_SB(0, 1), cB + hstepB, voffB); PG8_STAGE(PG8_SA(0, 1), cA + hstepA, voffA);
        if (wr == 1) PG8_BAR;
        PG8_WAIT_V(4); PG8_BAR;
        PG8_STAGE(PG8_SB(1, 0), cB + kstep, voffB); PG8_STAGE(PG8_SA(1, 0), cA + kstep, voffA); PG8_STAGE(PG8_SB(1, 1), cB + hstepB + kstep, voffB);
        PG8_WAIT_V(6); PG8_BAR;
    }
    for (;;) {
        const bool has_next = S.next(ui + 1, nxt);
        const char* nA = has_next ? (const char*)g.A + (size_t)nxt.pm * tstepA : cA; const char* nB = has_next ? (const char*)g.Bt + (size_t)nxt.pn * tstepB + S.b_extra(nxt) : cB;
        for (int t = 0; t < nt; t += 2) {
            const bool last = (t == nt - 2);
            const char* a1 = cA + (size_t)(t + 1) * kstep;
            const char* a2 = last ? nA : cA + (size_t)(t + 2) * kstep; const char* b2 = last ? nB : cB + (size_t)(t + 2) * kstep;
            const char* a3 = a2 + kstep; const char* b3 = b2 + kstep;
            if (last && has_next) S.a_ready(nxt);
            if constexpr (SP2) {
            PG8_LDB(B0, 0, 0); PG8_LDB(B1, 0, 1); PG8_SCHED; PG8_LDA(At, 0, 0); PG8_STAGE(PG8_SA(1, 1), a1 + hstepA, voffA);
            PG8_WAIT_V(8); PG8_WAIT_L(0); PG8_BAR; PG8_MMA(0, 0, At, B0); PG8_MMA(0, 1, At, B1); PG8_BAR; PG8_SCHED;
            PG8_LDA(At, 0, 1); PG8_STAGE(PG8_SB(0, 0), b2, voffB); PG8_STAGE(PG8_SB(0, 1), b2 + hstepB, voffB); PG8_STAGE(PG8_SA(0, 0), a2, voffA);
            PG8_WAIT_V(8); PG8_WAIT_L(0); PG8_BAR; PG8_MMA(1, 0, At, B0); PG8_MMA(1, 1, At, B1); PG8_BAR; PG8_SCHED;
            PG8_LDB(B0, 1, 0); PG8_LDB(B1, 1, 1); PG8_SCHED; PG8_LDA(At, 1, 0); PG8_STAGE(PG8_SA(0, 1), a2 + hstepA, voffA);
            PG8_WAIT_V(8); PG8_WAIT_L(0); PG8_BAR; PG8_MMA(0, 0, At, B0); PG8_MMA(0, 1, At, B1); PG8_BAR; PG8_SCHED;
            PG8_LDA(At, 1, 1); PG8_STAGE(PG8_SB(1, 0), b3, voffB); PG8_STAGE(PG8_SB(1, 1), b3 + hstepB, voffB); PG8_STAGE(PG8_SA(1, 0), a3, voffA);
            PG8_WAIT_V(8); PG8_WAIT_L(0); PG8_BAR; PG8_MMA(1, 0, At, B0); PG8_MMA(1, 1, At, B1); PG8_BAR; PG8_SCHED;
            } else {
            PG8_LDB(B0, 0, 0); PG8_SCHED; PG8_LDA(At, 0, 0); PG8_STAGE(PG8_SA(1, 1), a1 + hstepA, voffA);
            PG8_WAIT_L(8); PG8_BAR; PG8_WAIT_L(0); PG8_MMA(0, 0, At, B0); PG8_BAR; PG8_SCHED;
            PG8_LDB(B1, 0, 1); PG8_STAGE(PG8_SB(0, 0), b2, voffB);
            PG8_BAR; PG8_WAIT_L(0); PG8_MMA(0, 1, At, B1); PG8_BAR;
            PG8_LDA(At, 0, 1); PG8_STAGE(PG8_SA(0, 0), a2, voffA);
            PG8_BAR; PG8_WAIT_L(0); PG8_MMA(1, 0, At, B0); PG8_BAR; PG8_SCHED;
            PG8_STAGE(PG8_SB(0, 1), b2 + hstepB, voffB);
            PG8_WAIT_V(6); PG8_BAR; PG8_MMA(1, 1, At, B1); PG8_BAR;
            PG8_LDB(B0, 1, 0); PG8_SCHED; PG8_LDA(At, 1, 0); PG8_STAGE(PG8_SA(0, 1), a2 + hstepA, voffA);
            PG8_WAIT_L(8); PG8_BAR; PG8_WAIT_L(0); PG8_MMA(0, 0, At, B0); PG8_BAR; PG8_SCHED;
            PG8_LDB(B1, 1, 1); PG8_STAGE(PG8_SB(1, 0), b3, voffB);
            PG8_BAR; PG8_WAIT_L(0); PG8_MMA(0, 1, At, B1); PG8_BAR;
            PG8_LDA(At, 1, 1); PG8_STAGE(PG8_SA(1, 0), a3, voffA);
            PG8_BAR; PG8_WAIT_L(0); PG8_MMA(1, 0, At, B0); PG8_BAR; PG8_SCHED;
            PG8_STAGE(PG8_SB(1, 1), b3 + hstepB, voffB);
            PG8_WAIT_V(6); PG8_BAR; PG8_MMA(1, 1, At, B1); PG8_BAR;
            }
        }
        if constexpr (ALIGN_EPI) { if (wr == 0) PG8_BAR; }
        if constexpr (!Epi::AFTER_DRAIN) { int ln_; asm volatile("v_mbcnt_lo_u32_b32 %0, -1, 0\n\tv_mbcnt_hi_u32_b32 %0, -1, %0" : "=v"(ln_));
            E(acc, cur, wr, wc, ln_ & 15, ln_ >> 4); S.done(cur); }
        if (!has_next) break;
#pragma unroll
        for (int a = 0; a < 2; ++a)
#pragma unroll
            for (int b = 0; b < 2; ++b)
#pragma unroll
                for (int m = 0; m < 4; ++m)
#pragma unroll
                    for (int n = 0; n < 2; ++n) acc[a][b][m][n] = (f32x4){0.f, 0.f, 0.f, 0.f};
        cur = nxt; cA = nA; cB = nB; ++ui;
        if constexpr (ALIGN_EPI) { if (wr == 1) PG8_BAR; }
    }
    PG8_WAIT_V(0);
    if constexpr (!ALIGN_EPI) { if (wr == 0) PG8_BAR; }
    PG8_BAR;
    if constexpr (Epi::AFTER_DRAIN) { E.fused(acc, cur, wr, wc, fr, fq, lds, wid, lane); S.done(cur); }
#undef PG8_SA
#undef PG8_SB
#undef PG8_STAGE
#undef PG8_LDA
#undef PG8_LDB
#undef PG8_MMA
#undef PG8_WAIT_V
#undef PG8_WAIT_L
#undef PG8_BAR
#undef PG8_SCHED
}

__device__ __forceinline__ float bf_lo(unsigned w) { return __uint_as_float(w << 16); }
__device__ __forceinline__ float bf_hi(unsigned w) { return __uint_as_float(w & 0xffff0000u); }
__device__ __forceinline__ float sigmoidf_fast(float x) { return __builtin_amdgcn_rcpf(1.0f + __expf(-x)); }
__device__ __forceinline__ u32x4 pack8(const f32x4 a, const f32x4 b) { u32x4 w; w.x = cvt_pk_bf16(a[0], a[1]); w.y = cvt_pk_bf16(a[2], a[3]); w.z = cvt_pk_bf16(b[0], b[1]); w.w = cvt_pk_bf16(b[2], b[3]); return w; }

struct EpiInProj {
    static constexpr bool PERM = true, AFTER_DRAIN = false;
    bf16_t* P; float* BA; int ldp; int npn;
    __device__ __forceinline__ void operator()(const f32x4 (&acc)[2][2][4][2], const Unit& u, int wr, int wc, int fr, int fq) const {
        const int row0 = u.pm * BM + wr * 64 + fr;
        if (u.pn < npn) {
            const int col0 = u.pn * BM + wc * 32 + 8 * fq;
#pragma unroll
            for (int ai = 0; ai < 2; ++ai)
#pragma unroll
                for (int m = 0; m < 4; ++m) { bf16_t* rowp = P + (size_t)(row0 + ai * HALF + m * 16) * ldp + col0;
#pragma unroll
                    for (int bj = 0; bj < 2; ++bj) *(u32x4*)(rowp + bj * HALF) = pack8(acc[ai][bj][m][0], acc[ai][bj][m][1]); }
        } else if (wc == 0 && fq < 2) {
#pragma unroll
            for (int ai = 0; ai < 2; ++ai)
#pragma unroll
                for (int m = 0; m < 4; ++m) { float* rp = BA + (size_t)(row0 + ai * HALF + m * 16) * 16 + 8 * fq;
                    *(f32x4*)rp = acc[ai][0][m][0]; *(f32x4*)(rp + 4) = acc[ai][0][m][1]; }
        }
    }
};
template <int MODE> struct EpiBranch {
    static constexpr bool PERM = true, AFTER_DRAIN = false;
    const bf16_t* G; int ldg; float* MGf; bf16_t* MG; int ldc;
    __device__ __forceinline__ void operator()(const f32x4 (&acc)[2][2][4][2], const Unit& u, int wr, int wc, int fr, int fq) const {
        const int row0 = u.pm * BM + wr * 64 + fr, col0 = u.pn * BM + wc * 32 + 8 * fq;
#pragma unroll
        for (int ai = 0; ai < 2; ++ai)
#pragma unroll
            for (int m = 0; m < 4; ++m) { const size_t row = (size_t)(row0 + ai * HALF + m * 16);
#pragma unroll
                for (int bj = 0; bj < 2; ++bj) { const int col = col0 + bj * HALF;
                    const u32x4 gw = *(const u32x4*)(G + row * ldg + col);
                    f32x4 s0, s1; s0[0] = sigmoidf_fast(bf_lo(gw.x)); s0[1] = sigmoidf_fast(bf_hi(gw.x)); s0[2] = sigmoidf_fast(bf_lo(gw.y)); s0[3] = sigmoidf_fast(bf_hi(gw.y));
                    s1[0] = sigmoidf_fast(bf_lo(gw.z)); s1[1] = sigmoidf_fast(bf_hi(gw.z)); s1[2] = sigmoidf_fast(bf_lo(gw.w)); s1[3] = sigmoidf_fast(bf_hi(gw.w));
                    f32x4 v0 = acc[ai][bj][m][0] * s0, v1 = acc[ai][bj][m][1] * s1;
                    float* mp = MGf + row * ldc + col;
                    if (MODE >= 1) { v0 = v0 + *(const f32x4*)mp; v1 = v1 + *(const f32x4*)(mp + 4); }
                    if (MODE <= 1) { *(f32x4*)mp = v0; *(f32x4*)(mp + 4) = v1; }
                    else *(u32x4*)(MG + row * ldc + col) = pack8(v0, v1); } }
    }
};
struct EpiResid {
    static constexpr bool PERM = true, AFTER_DRAIN = false;
    float* X; int ldc;
    __device__ __forceinline__ void operator()(const f32x4 (&acc)[2][2][4][2], const Unit& u, int wr, int wc, int fr, int fq) const {
        const int row0 = u.pm * BM + wr * 64 + fr, col0 = u.pn * BM + wc * 32 + 8 * fq;
#pragma unroll
        for (int ai = 0; ai < 2; ++ai)
#pragma unroll
            for (int m = 0; m < 4; ++m) { float* rowp = X + (size_t)(row0 + ai * HALF + m * 16) * ldc + col0;
#pragma unroll
                for (int bj = 0; bj < 2; ++bj) { float* p = rowp + bj * HALF;
                    const f32x4 a = *(const f32x4*)p, b = *(const f32x4*)(p + 4);
                    *(f32x4*)p = a + acc[ai][bj][m][0]; *(f32x4*)(p + 4) = b + acc[ai][bj][m][1]; } }
    }
};
struct EpiUp {
    static constexpr bool PERM = true, AFTER_DRAIN = false;
    bf16_t* H; int ldc;
    __device__ __forceinline__ void operator()(const f32x4 (&acc)[2][2][4][2], const Unit& u, int wr, int wc, int fr, int fq) const {
        const int row0 = u.pm * BM + wr * 64 + fr, col0 = u.pn * BM + wc * 32 + 8 * fq;
#pragma unroll
        for (int ai = 0; ai < 2; ++ai)
#pragma unroll
            for (int m = 0; m < 4; ++m) { bf16_t* rowp = H + (size_t)(row0 + ai * HALF + m * 16) * ldc + col0;
#pragma unroll
                for (int bj = 0; bj < 2; ++bj) { f32x4 a = acc[ai][bj][m][0], b = acc[ai][bj][m][1];
#pragma unroll
                    for (int j = 0; j < 4; ++j) { const float x = a[j] > 0.f ? a[j] : 0.f, y = b[j] > 0.f ? b[j] : 0.f; a[j] = x * x; b[j] = y * y; }
                    *(u32x4*)(rowp + bj * HALF) = pack8(a, b); } }
    }
};
struct EpiPool {
    static constexpr bool PERM = true, AFTER_DRAIN = false;
    bf16_t* O; const float* scale; int ldc; int tpg;
    __device__ __forceinline__ void operator()(const f32x4 (&acc)[2][2][4][2], const Unit& u, int wr, int wc, int fr, int fq) const {
        const int g = u.pm / tpg, rt = u.pm - g * tpg;
        const int row0 = rt * BM + wr * 64 + fr, col0 = g * BM + wc * 32 + 8 * fq;
#pragma unroll
        for (int bj = 0; bj < 2; ++bj) { const f32x4 sc0 = *(const f32x4*)(scale + col0 + bj * HALF), sc1 = *(const f32x4*)(scale + col0 + bj * HALF + 4);
#pragma unroll
            for (int ai = 0; ai < 2; ++ai)
#pragma unroll
                for (int m = 0; m < 4; ++m) { bf16_t* rowp = O + (size_t)(row0 + ai * HALF + m * 16) * ldc + col0 + bj * HALF;
                    *(u32x4*)rowp = pack8(acc[ai][bj][m][0] * sc0, acc[ai][bj][m][1] * sc1); } }
    }
};
}

constexpr int NWAVES = 8, NTHREADS = NWAVES * 64;
constexpr int D = 2048, NB = 4, T = 2048, DEPTH = 4, SB = 128, ST = 8;
constexpr int MP = NB * T, MS = SB * ST, M = MP + MS;
constexpr int LW = 1024, NH = 8, HD = 128, QKVW = 3072, PLW = 1024, PBUF = 15, FF = 8192;
constexpr int NIN = 13328, NINP = 13568, PW = 13312;
constexpr int C_XL = 0, C_GL = 1024, C_Q = 2048, C_K = 3072, C_V = 4096, C_Z = 5120, C_POOL = 6144, C_GLRU = 7168, C_GDN = 9216, C_GPOOL = 11264;
constexpr float EPS = 1e-6f;
static_assert(M % 256 == 0 && PW % 256 == 0 && NINP % 256 == 0, "tiles");

enum { I_XP = 0, I_XS, I_SLH, I_SLC, I_SDS, I_SDC, I_SPL, I_NMIX, I_WIN, I_LCW, I_LCB, I_LAW, I_LAB, I_LXW, I_LXB, I_LLAM, I_DCW, I_DALOG, I_DDT, I_DNW, I_PW, I_PSC,
       I_WBL, I_WBD, I_WBP, I_WOUT, I_NMLP, I_WUP, I_WDN, I_NFIN, N_INPUTS };
constexpr size_t O_YP = 0, O_YS = O_YP + (size_t)MP * D, O_PLH = O_YS + (size_t)MS * D, O_PLC = O_PLH + (size_t)DEPTH * NB * LW, O_PDS = O_PLC + (size_t)DEPTH * NB * 3 * LW,
                 O_PDC = O_PDS + (size_t)DEPTH * NB * NH * HD * HD, O_PPL = O_PDC + (size_t)DEPTH * NB * 3 * QKVW, O_SLH = O_PPL + (size_t)DEPTH * NB * PBUF * PLW,
                 O_SLC = O_SLH + (size_t)DEPTH * SB * LW, O_SDS = O_SLC + (size_t)DEPTH * SB * 3 * LW, O_SDC = O_SDS + (size_t)DEPTH * SB * NH * HD * HD,
                 O_SPL = O_SDC + (size_t)DEPTH * SB * 3 * QKVW, O_END = O_SPL + (size_t)DEPTH * SB * PBUF * PLW;

#define AS4 __attribute__((address_space(4)))
struct Args { const float* in[N_INPUTS]; float* out; unsigned char* ws; int l_lo, l_hi, ph_lo, ph_hi, flags, pad; };
static_assert(sizeof(Args) == N_INPUTS * 8 + 16 + 24, "Args has no padding");

typedef unsigned short bf16;
constexpr size_t MiB = 1u << 20;
constexpr size_t WS_CTL = 0, CTL_ZERO_BYTES = 1 * MiB;
constexpr size_t WL_IN = 0, WL_BR = WL_IN + (size_t)NINP * D, WL_OUT = WL_BR + 3 * (size_t)D * LW, WL_UP = WL_OUT + (size_t)D * D, WL_DN = WL_UP + (size_t)FF * D,
                 WL_POOL = WL_DN + (size_t)D * FF, WL_ELEMS = WL_POOL + 4 * 256 * 256;
constexpr size_t WS_W = 1 * MiB, WS_W_END = WS_W + DEPTH * WL_ELEMS * 2;
constexpr size_t al256(size_t x) { return (x + 255) & ~(size_t)255; }
constexpr size_t WS_X = al256(WS_W_END);
constexpr size_t WS_XN = WS_X + (size_t)M * D * 4;
constexpr size_t WS_P = WS_XN + (size_t)M * D * 2;
constexpr size_t WS_HM = WS_P;
constexpr size_t WS_BA = WS_P + (size_t)M * PW * 2;
constexpr size_t WS_OL = WS_BA + (size_t)M * 16 * 4;
constexpr size_t WS_OD = WS_OL + (size_t)M * LW * 2;
constexpr size_t WS_OP = WS_OD + (size_t)M * LW * 2;
constexpr size_t WS_PD = WS_OP + (size_t)M * LW * 2;
constexpr size_t WS_MGF = WS_PD + (size_t)M * LW * 2;
constexpr size_t WS_MG = WS_MGF + (size_t)M * D * 4;
constexpr size_t WS_DNP = WS_MG + (size_t)M * D * 2;
constexpr size_t DNP_BLOB = 73728 + 256;
constexpr size_t WS_DNP_END = al256(WS_DNP + (size_t)NB * NH * (T / 64) * DNP_BLOB);
constexpr size_t WS_ALRU = WS_DNP_END;
constexpr size_t WS_BLRU = WS_ALRU + (size_t)M * LW * 4;
constexpr size_t WS_QN = WS_BLRU + (size_t)M * LW * 4;
constexpr size_t WS_KN = WS_QN + (size_t)M * LW * 4;
constexpr size_t WS_VN = WS_KN + (size_t)M * LW * 4;
constexpr size_t WS_BG = WS_VN + (size_t)M * LW * 4;
constexpr size_t WS_END = WS_BG + (size_t)M * 16 * 4;
static_assert((size_t)M * FF * 2 <= (size_t)M * PW * 2, "HM fits inside P");
static_assert(WS_X % 256 == 0 && WS_XN % 256 == 0 && WS_P % 256 == 0 && WS_BA % 256 == 0 && WS_OL % 256 == 0 && WS_PD % 256 == 0 && WS_MGF % 256 == 0 && WS_MG % 256 == 0 && WS_DNP % 256 == 0, "ws alignment");

constexpr int CW_TMO = 0, CW_CODE = 1;
constexpr int CW_BAR = 4096;
constexpr int CW_QUEUE = 16384;

constexpr int RING_OFF = 0, RING_BYTES = 131072;
constexpr int LDS_BYTES = 160 * 1024;
constexpr int MISC_OFF = LDS_BYTES - 256;

#define GAS __attribute__((address_space(1)))
#define LAS __attribute__((address_space(3)))
typedef unsigned v4u __attribute__((ext_vector_type(4)));
typedef unsigned v2u __attribute__((ext_vector_type(2)));
typedef float f32x4 __attribute__((ext_vector_type(4)));
typedef float f32x2 __attribute__((ext_vector_type(2)));
typedef float f32x16 __attribute__((ext_vector_type(16)));
typedef short bf16x8 __attribute__((ext_vector_type(8)));
typedef GAS unsigned gu32;
#define RLX_AGENT __ATOMIC_RELAXED, __HIP_MEMORY_SCOPE_AGENT
#define LDS_WAIT() asm volatile("s_waitcnt lgkmcnt(0)" ::: "memory")
#define VM_WAIT() asm volatile("s_waitcnt vmcnt(0)" ::: "memory")
typedef __bf16 bf16x2_t __attribute__((ext_vector_type(2)));
__device__ __forceinline__ unsigned pk2(float lo, float hi) { f32x2 v = {lo, hi}; bf16x2_t b = __builtin_convertvector(v, bf16x2_t); return __builtin_bit_cast(unsigned, b); }
__device__ __forceinline__ float bflo(unsigned w) { return __uint_as_float(w << 16); }
__device__ __forceinline__ float bfhi(unsigned w) { return __uint_as_float(w & 0xffff0000u); }
__device__ __forceinline__ float bf2f(bf16 h) { return __uint_as_float(((unsigned)h) << 16); }
__device__ __forceinline__ float sigm(float x) { return 1.0f / (1.0f + __expf(-x)); }
__device__ __forceinline__ float siluf(float x) { return x / (1.0f + __expf(-x)); }
__device__ __forceinline__ float softplusf(float x) { return x > 20.f ? x : log1pf(__expf(x)); }
__device__ __forceinline__ float wave_sum(float v) {
#pragma unroll
    for (int o = 1; o < 64; o <<= 1) v += __shfl_xor(v, o);
    return v;
}
#define XB_TMO      128
#define XB_XCNT(j)  (256  + 64 * (j))
#define XB_XSUB(j)  (1280 + 64 * (j))
#define XB_XGEN(j)  (2304 + 64 * (j))
#define XB_TOP      3328
#define XB_TOPGEN   3392
#define XCD_BAR_WORDS 3456
#define XB_SPIN_CAP (1u << 18)

__device__ __forceinline__ unsigned xb_ld(unsigned* p)              { return __hip_atomic_load(p, __ATOMIC_RELAXED, __HIP_MEMORY_SCOPE_AGENT); }
__device__ __forceinline__ unsigned xb_add(unsigned* p, unsigned v) { return __hip_atomic_fetch_add(p, v, __ATOMIC_RELAXED, __HIP_MEMORY_SCOPE_AGENT); }
__device__ __forceinline__ unsigned xb_xcc_id() { return (unsigned)__builtin_amdgcn_s_getreg((3 << 11) | 20) & 0xFu; }
#define XB_SPIN(cond, bar) do { unsigned _sp = 0; while (cond) { __builtin_amdgcn_s_sleep(1); \
    if ((++_sp & 255u) == 0u) { if (xb_ld(&(bar)[XB_TMO])) break; if (_sp > XB_SPIN_CAP) { atomicAdd(&(bar)[XB_TMO], 1u); break; } } } } while (0)

struct XcdBarrier {
    unsigned* bar; unsigned x;
    volatile LAS unsigned* st;
};

__device__ __forceinline__ XcdBarrier xcd_barrier_post(unsigned* bar, volatile LAS unsigned* st, const int xb_tid) {
    XcdBarrier b; b.bar = bar; b.x = xb_xcc_id(); b.st = st;
    if (xb_tid == 0) (void)xb_add(&bar[XB_XCNT(b.x)], 1u);
    return b;
}
__device__ __forceinline__ void xcd_barrier_complete(unsigned* bar, unsigned x, unsigned& nloc, unsigned& nx) {
    const unsigned G = gridDim.x * gridDim.y * gridDim.z;
    unsigned sum, cnt, mine, sp = 0u;
    for (;;) {
        sum = 0u; cnt = 0u; mine = 0u;
#pragma unroll
        for (unsigned j = 0; j < 16; ++j) { const unsigned c = xb_ld(&bar[XB_XCNT(j)]); sum += c; cnt += (c > 0u) ? 1u : 0u; mine = (j == x) ? c : mine; }
        if (sum == G) break;
        __builtin_amdgcn_s_sleep(1);
        if ((++sp & 255u) == 0u) { if (xb_ld(&bar[XB_TMO])) break; if (sp > XB_SPIN_CAP) { atomicAdd(&bar[XB_TMO], 1u); break; } }
    }
    nloc = mine > 0u ? mine : 1u; nx = cnt > 0u ? cnt : 1u;
}

__device__ __forceinline__ void xcd_barrier(const XcdBarrier& b, const int xb_tid) {
    asm volatile("s_waitcnt vmcnt(0)" ::: "memory");
    __syncthreads();
    if (xb_tid == 0) {
        unsigned* bar = b.bar;
        __builtin_amdgcn_s_waitcnt(0);
        unsigned nloc = b.st[0], nx = b.st[1];
        if (nloc == 0u) { xcd_barrier_complete(bar, b.x, nloc, nx); b.st[0] = nloc; b.st[1] = nx; }
        const unsigned old = xb_add(&bar[XB_XSUB(b.x)], 1u);
        const unsigned gen = old / nloc;
        if (old + 1u == (gen + 1u) * nloc) {
            __builtin_amdgcn_fence(__ATOMIC_RELEASE, "agent");
            asm volatile("s_waitcnt vmcnt(0)" ::: "memory");
            const unsigned og = xb_add(&bar[XB_TOP], 1u);
            const unsigned tg = og / nx;
            if (og + 1u == (tg + 1u) * nx) xb_add(&bar[XB_TOPGEN], 1u);
            else XB_SPIN(xb_ld(&bar[XB_TOPGEN]) == tg, bar);
            __builtin_amdgcn_fence(__ATOMIC_ACQUIRE, "agent");
            xb_add(&bar[XB_XGEN(b.x)], 1u);
            asm volatile("s_waitcnt vmcnt(0)" ::: "memory");
        } else {
            XB_SPIN(xb_ld(&bar[XB_XGEN(b.x)]) == gen, bar);
            __builtin_amdgcn_fence(__ATOMIC_ACQUIRE, "agent");
            asm volatile("s_waitcnt vmcnt(0)" ::: "memory");
        }
    }
    __syncthreads();
}

struct Frame {
    LAS unsigned char* lds;
    volatile LAS unsigned* MISC;
    gu32* ctl;
    int tid, lane, wave;
    int G, bx;
    const AS4 Args* ka;
    float* out; unsigned char* ws;
};
#define FIN(F, k) ((const float*)(const GAS float*)((F).ka->in[(k)]))

constexpr int TP_PITCH = 260;
constexpr int TP_TILE_BYTES = 128 * TP_PITCH;
constexpr int TILES_IN = 16 * (NINP / 128), TILES_BR = 8 * 16, TILES_OUT = 16 * 16, TILES_UP = 16 * 64, TILES_DN = 64 * 16, TILES_POOL = 16;
constexpr int TILES_LAYER = TILES_IN + 3 * TILES_BR + TILES_OUT + TILES_UP + TILES_DN + TILES_POOL;
struct TileDesc { const float* W; bf16* Bt; int ldw, K, k0, n0, remap; };
__device__ __forceinline__ TileDesc p0_tile(Frame& F, int it) {
    TileDesc d; const int l = it / TILES_LAYER; int r = it - l * TILES_LAYER;
    bf16* wl = (bf16*)(F.ws + WS_W) + (size_t)l * WL_ELEMS; d.remap = 0;
    if (r < TILES_IN) { const int nbn = NINP / 128; d.W = FIN(F, I_WIN) + (size_t)l * D * NIN; d.ldw = NIN; d.K = D; d.Bt = wl + WL_IN; d.k0 = 128 * (r / nbn); d.n0 = 128 * (r % nbn); d.remap = 1; return d; }
    r -= TILES_IN;
    if (r < 3 * TILES_BR) { const int b = r / TILES_BR, rr = r - b * TILES_BR; const float* src = b == 0 ? FIN(F, I_WBL) : (b == 1 ? FIN(F, I_WBD) : FIN(F, I_WBP));
        d.W = src + (size_t)l * LW * D; d.ldw = D; d.K = LW; d.Bt = wl + WL_BR + (size_t)b * D * LW; d.k0 = 128 * (rr / 16); d.n0 = 128 * (rr % 16); return d; }
    r -= 3 * TILES_BR;
    if (r < TILES_OUT) { d.W = FIN(F, I_WOUT) + (size_t)l * D * D; d.ldw = D; d.K = D; d.Bt = wl + WL_OUT; d.k0 = 128 * (r / 16); d.n0 = 128 * (r % 16); return d; }
    r -= TILES_OUT;
    if (r < TILES_UP) { d.W = FIN(F, I_WUP) + (size_t)l * D * FF; d.ldw = FF; d.K = D; d.Bt = wl + WL_UP; d.k0 = 128 * (r / 64); d.n0 = 128 * (r % 64); return d; }
    r -= TILES_UP;
    if (r < TILES_DN) { d.W = FIN(F, I_WDN) + (size_t)l * FF * D; d.ldw = D; d.K = FF; d.Bt = wl + WL_DN; d.k0 = 128 * (r / 16); d.n0 = 128 * (r % 16); return d; }
    r -= TILES_DN;
    { const int g = r / 4, rr = r & 3; d.W = FIN(F, I_PW) + (size_t)l * 4 * 65536 + (size_t)g * 65536; d.ldw = 256; d.K = 256; d.Bt = wl + WL_POOL + (size_t)g * 65536; d.k0 = 128 * (rr >> 1); d.n0 = 128 * (rr & 1); return d; }
}
__device__ __forceinline__ int win_src(int n) { return n < 6144 ? n : (n < 13312 ? n + 16 : (n < 13328 ? n - 7168 : -1)); }
__device__ __forceinline__ void p0_load(const TileDesc& d, int tid, f32x4 (&v)[8]) {
    const int n4 = tid & 31, kr = tid >> 5; const int nd = d.n0 + 4 * n4; const int src = d.remap ? win_src(nd) : nd;
#pragma unroll
    for (int i = 0; i < 8; ++i) { const int k = d.k0 + kr + 16 * i;
        v[i] = src >= 0 ? *(const GAS f32x4*)(d.W + (size_t)k * d.ldw + src) : (f32x4){0.f, 0.f, 0.f, 0.f}; }
}
__device__ __forceinline__ void p0_prologue(Frame& F) {
    const int tid = F.tid, NT = DEPTH * TILES_LAYER;
    f32x4 v[8]; TileDesc d, dn; int it = F.bx; int buf = 0;
    if (it < NT) { d = p0_tile(F, it); p0_load(d, tid, v); }
    for (; it < NT; it += F.G) {
        LAS unsigned char* tile = F.lds + buf * TP_TILE_BYTES;
        { const int n4 = tid & 31, kr = tid >> 5;
#pragma unroll
          for (int i = 0; i < 8; ++i) { LAS unsigned* p = (LAS unsigned*)(tile + (kr + 16 * i) * TP_PITCH + 8 * n4); p[0] = pk2(v[i][0], v[i][1]); p[1] = pk2(v[i][2], v[i][3]); } }
        const int itn = it + F.G; if (itn < NT) { dn = p0_tile(F, itn); p0_load(dn, tid, v); }
        LDS_WAIT(); __builtin_amdgcn_s_barrier(); asm volatile("" ::: "memory");
        { const int koct = tid & 7, nn = tid >> 3;
#pragma unroll
          for (int h = 0; h < 2; ++h)
#pragma unroll
            for (int nr = 0; nr < 2; ++nr) { const int n = nn + 64 * nr, kk = 8 * (koct + 8 * h);
                const LAS unsigned short* s = (const LAS unsigned short*)(tile + kk * TP_PITCH + 2 * n);
                v4u o; o.x = (unsigned)s[0] | ((unsigned)s[1 * TP_PITCH / 2] << 16); o.y = (unsigned)s[2 * TP_PITCH / 2] | ((unsigned)s[3 * TP_PITCH / 2] << 16);
                o.z = (unsigned)s[4 * TP_PITCH / 2] | ((unsigned)s[5 * TP_PITCH / 2] << 16); o.w = (unsigned)s[6 * TP_PITCH / 2] | ((unsigned)s[7 * TP_PITCH / 2] << 16);
                *(GAS v4u*)(d.Bt + (size_t)(d.n0 + n) * d.K + d.k0 + kk) = o; } }
        d = dn; buf ^= 1;
    }
    { GAS f32x4* X = (GAS f32x4*)(F.ws + WS_X); const GAS f32x4* xp = (const GAS f32x4*)FIN(F, I_XP); const GAS f32x4* xs = (const GAS f32x4*)FIN(F, I_XS);
      const size_t np = (size_t)MP * D / 4, ns = (size_t)MS * D / 4, stride = (size_t)F.G * NTHREADS;
      for (size_t i = (size_t)F.bx * NTHREADS + tid; i < np; i += stride) X[i] = xp[i];
      for (size_t i = (size_t)F.bx * NTHREADS + tid; i < ns; i += stride) X[np + i] = xs[i]; }
    LDS_WAIT(); __builtin_amdgcn_s_barrier();
}

__device__ __forceinline__ void rms_rows_bf16(Frame& F, const float* X, const float* gain, bf16* XN) {
    const int gw = F.bx * NWAVES + F.wave, NGW = F.G * NWAVES;
    f32x4 gv[8];
#pragma unroll
    for (int j = 0; j < 8; ++j) gv[j] = ((const GAS f32x4*)gain)[F.lane + 64 * j];
    for (int m = gw; m < M; m += NGW) {
        const GAS f32x4* xr = (const GAS f32x4*)(X + (size_t)m * D) + F.lane; f32x4 v[8]; float s = 0.f;
#pragma unroll
        for (int j = 0; j < 8; ++j) { v[j] = xr[64 * j]; s += (v[j][0] * v[j][0] + v[j][1] * v[j][1]) + (v[j][2] * v[j][2] + v[j][3] * v[j][3]); }
        const float rstd = 1.0f / sqrtf(wave_sum(s) * (1.f / D) + EPS);
        GAS v2u* o = (GAS v2u*)(XN + (size_t)m * D) + F.lane;
#pragma unroll
        for (int j = 0; j < 8; ++j) { v2u w; w.x = pk2(v[j][0] * rstd * gv[j][0], v[j][1] * rstd * gv[j][1]); w.y = pk2(v[j][2] * rstd * gv[j][2], v[j][3] * rstd * gv[j][3]); o[64 * j] = w; }
    }
}
__device__ __forceinline__ void rms_rows_f32(Frame& F, const float* X, const float* gain, float* Y) {
    const int gw = F.bx * NWAVES + F.wave, NGW = F.G * NWAVES;
    f32x4 gv[8];
#pragma unroll
    for (int j = 0; j < 8; ++j) gv[j] = ((const GAS f32x4*)gain)[F.lane + 64 * j];
    for (int m = gw; m < M; m += NGW) {
        const GAS f32x4* xr = (const GAS f32x4*)(X + (size_t)m * D) + F.lane; f32x4 v[8]; float s = 0.f;
#pragma unroll
        for (int j = 0; j < 8; ++j) { v[j] = xr[64 * j]; s += (v[j][0] * v[j][0] + v[j][1] * v[j][1]) + (v[j][2] * v[j][2] + v[j][3] * v[j][3]); }
        const float rstd = 1.0f / sqrtf(wave_sum(s) * (1.f / D) + EPS);
        GAS f32x4* o = (GAS f32x4*)(Y + (size_t)m * D) + F.lane;
#pragma unroll
        for (int j = 0; j < 8; ++j) o[64 * j] = v[j] * rstd * gv[j];
    }
}

__device__ __forceinline__ void state_outputs(Frame& F, int l) {
    const bf16* P = (const bf16*)(F.ws + WS_P);
    const size_t gid = (size_t)F.bx * NTHREADS + F.tid, gstride = (size_t)F.G * NTHREADS;
    for (size_t i = gid; i < (size_t)NB * 3 * LW; i += gstride) { const int c = i % LW, j = (i / LW) % 3, b = i / (3 * LW);
        F.out[O_PLC + (size_t)l * NB * 3 * LW + i] = bf2f(P[(size_t)(b * T + T - 3 + j) * PW + C_XL + c]); }
    for (size_t i = gid; i < (size_t)SB * 3 * LW; i += gstride) { const int c = i % LW, j = (i / LW) % 3, b = i / (3 * LW);
        F.out[O_SLC + (size_t)l * SB * 3 * LW + i] = bf2f(P[(size_t)(MP + b * ST + ST - 3 + j) * PW + C_XL + c]); }
    for (size_t i = gid; i < (size_t)NB * 3 * QKVW; i += gstride) { const int c = i % QKVW, j = (i / QKVW) % 3, b = i / (3 * QKVW);
        F.out[O_PDC + (size_t)l * NB * 3 * QKVW + i] = bf2f(P[(size_t)(b * T + T - 3 + j) * PW + C_Q + c]); }
    for (size_t i = gid; i < (size_t)SB * 3 * QKVW; i += gstride) { const int c = i % QKVW, j = (i / QKVW) % 3, b = i / (3 * QKVW);
        F.out[O_SDC + (size_t)l * SB * 3 * QKVW + i] = bf2f(P[(size_t)(MP + b * ST + ST - 3 + j) * PW + C_Q + c]); }
    for (size_t i = gid; i < (size_t)NB * PBUF * PLW; i += gstride) { const int c = i % PLW, j = (i / PLW) % PBUF, b = i / (PBUF * PLW);
        F.out[O_PPL + (size_t)l * NB * PBUF * PLW + i] = bf2f(P[(size_t)(b * T + T - PBUF + j) * PW + C_POOL + c]); }
    const float* spl = FIN(F, I_SPL) + (size_t)l * SB * PBUF * PLW;
    for (size_t i = gid; i < (size_t)SB * PBUF * PLW; i += gstride) { const int c = i % PLW, j = (i / PLW) % PBUF, b = i / (PBUF * PLW);
        F.out[O_SPL + (size_t)l * SB * PBUF * PLW + i] = (j < PBUF - ST) ? spl[((size_t)b * PBUF + j + ST) * PLW + c] : bf2f(P[(size_t)(MP + b * ST + j - (PBUF - ST)) * PW + C_POOL + c]); }
}

struct RowInfo { int smp, b, t, row0; };
__device__ __forceinline__ RowInfo row_info(int row) { RowInfo r; if (row < MP) { r.smp = 0; r.b = row / T; r.t = row - r.b * T; r.row0 = r.b * T; } else { const int q = row - MP; r.smp = 1; r.b = q / ST; r.t = q - r.b * ST; r.row0 = MP + r.b * ST; } return r; }

__device__ __forceinline__ void lru_gates_unit(Frame& F, int l, int unit) {
    const int rt = unit / 16, n = unit % 16, tid = F.tid, d = tid & 63, rg = tid >> 6;
    const bf16* P = (const bf16*)(F.ws + WS_P);
    LAS float* xcs = (LAS float*)F.lds;
    const int ch = n * 64 + d;
    const float* cw = FIN(F, I_LCW) + (size_t)l * 4 * LW; const float cb = FIN(F, I_LCB)[(size_t)l * LW + ch];
    const float w0 = cw[ch], w1 = cw[LW + ch], w2 = cw[2 * LW + ch], w3 = cw[3 * LW + ch];
    const float* hist = FIN(F, I_SLC) + (size_t)l * SB * 3 * LW;
    float xc[8];
#pragma unroll
    for (int i = 0; i < 8; ++i) { const int row = rt * 64 + rg * 8 + i; const RowInfo ri = row_info(row);
        float xm[4];
#pragma unroll
        for (int j = 0; j < 4; ++j) { const int tt = ri.t + j - 3;
            xm[j] = tt >= 0 ? bf2f(P[(size_t)(ri.row0 + tt) * PW + C_XL + ch]) : (ri.smp ? hist[((size_t)ri.b * 3 + (tt + 3)) * LW + ch] : 0.f); }
        xc[i] = w0 * xm[0] + w1 * xm[1] + w2 * xm[2] + w3 * xm[3] + cb;
        xcs[(rg * 8 + i) * 64 + d] = xc[i]; }
    __syncthreads();
    const float* wa = FIN(F, I_LAW) + ((size_t)l * 16 + n) * 4096; const float* wx = FIN(F, I_LXW) + ((size_t)l * 16 + n) * 4096;
    float ra[8], rx[8];
#pragma unroll
    for (int i = 0; i < 8; ++i) { ra[i] = 0.f; rx[i] = 0.f; }
    for (int c = 0; c < 64; ++c) { const float a = wa[c * 64 + d], x = wx[c * 64 + d];
#pragma unroll
        for (int i = 0; i < 8; ++i) { const float v = xcs[(rg * 8 + i) * 64 + c]; ra[i] += v * a; rx[i] += v * x; } }
    const float ba = FIN(F, I_LAB)[(size_t)l * LW + ch], bx = FIN(F, I_LXB)[(size_t)l * LW + ch], lam = FIN(F, I_LLAM)[(size_t)l * LW + ch];
    const float sp = softplusf(-lam);
    float* A = (float*)(F.ws + WS_ALRU); float* B = (float*)(F.ws + WS_BLRU);
#pragma unroll
    for (int i = 0; i < 8; ++i) { const int row = rt * 64 + rg * 8 + i;
        const float r = sigm(ra[i] + ba), ig = sigm(rx[i] + bx), la = -8.0f * r * sp, a = __expf(la);
        A[(size_t)row * LW + ch] = a; B[(size_t)row * LW + ch] = sqrtf(-expm1f(2.0f * la)) * (ig * xc[i]); }
    __syncthreads();
}
__device__ __forceinline__ void dn_pre_item(Frame& F, int l, int item) {
    const int row = item >> 3, h = item & 7, lane = F.lane; const RowInfo ri = row_info(row);
    const bf16* P = (const bf16*)(F.ws + WS_P);
    const float* cw = FIN(F, I_DCW) + (size_t)l * 4 * QKVW; const float* hist = FIN(F, I_SDC) + (size_t)l * SB * 3 * QKVW;
    float val[3][2];
#pragma unroll
    for (int s = 0; s < 3; ++s)
#pragma unroll
        for (int e = 0; e < 2; ++e) { const int c = s * 1024 + h * 128 + 2 * lane + e; float acc = 0.f;
#pragma unroll
            for (int j = 0; j < 4; ++j) { const int tt = ri.t + j - 3;
                const float x = tt >= 0 ? bf2f(P[(size_t)(ri.row0 + tt) * PW + C_Q + c]) : (ri.smp ? hist[((size_t)ri.b * 3 + (tt + 3)) * QKVW + c] : 0.f);
                acc += cw[j * QKVW + c] * x; }
            val[s][e] = siluf(acc); }
    const float qs = wave_sum(val[0][0] * val[0][0] + val[0][1] * val[0][1]), ks = wave_sum(val[1][0] * val[1][0] + val[1][1] * val[1][1]);
    const float qn = (1.0f / sqrtf(qs + EPS)) * 0.08838834764831845f, kn = 1.0f / sqrtf(ks + EPS);
    float* QN = (float*)(F.ws + WS_QN); float* KN = (float*)(F.ws + WS_KN); float* VN = (float*)(F.ws + WS_VN);
    const size_t o = (size_t)row * LW + h * 128 + 2 * lane;
    *(f32x2*)(QN + o) = (f32x2){val[0][0] * qn, val[0][1] * qn}; *(f32x2*)(KN + o) = (f32x2){val[1][0] * kn, val[1][1] * kn}; *(f32x2*)(VN + o) = (f32x2){val[2][0], val[2][1]};
    if (lane == 0) { const float* BA = (const float*)(F.ws + WS_BA) + (size_t)row * 16;
        float* BG = (float*)(F.ws + WS_BG) + (size_t)row * 16;
        BG[h] = sigm(BA[h]);
        BG[8 + h] = -__expf(FIN(F, I_DALOG)[l * NH + h]) * softplusf(BA[8 + h] + FIN(F, I_DDT)[l * NH + h]); }
}
__device__ __forceinline__ void pool_d_rows(Frame& F, int l) {
    const bf16* P = (const bf16*)(F.ws + WS_P); bf16* PD = (bf16*)(F.ws + WS_PD);
    const float* hist = FIN(F, I_SPL) + (size_t)l * SB * PBUF * PLW;
    const size_t total = (size_t)M * (PLW / 2), stride = (size_t)F.G * NTHREADS;
    for (size_t i = (size_t)F.bx * NTHREADS + F.tid; i < total; i += stride) {
        const int row = (int)(i / (PLW / 2)), c = 2 * (int)(i % (PLW / 2)), g = c >> 8, w = 2 << g; const RowInfo ri = row_info(row);
        float s0 = 0.f, s1 = 0.f, u0 = 0.f, u1 = 0.f;
        for (int j = 0; j < w; ++j) { const int tt = ri.t - j; float x0, x1;
            if (tt >= 0) { const unsigned pw = *(const unsigned*)(P + (size_t)(ri.row0 + tt) * PW + C_POOL + c); x0 = bflo(pw); x1 = bfhi(pw); }
            else if (ri.smp) { const float* hp = hist + ((size_t)ri.b * PBUF + (PBUF + tt)) * PLW + c; x0 = hp[0]; x1 = hp[1]; }
            else { x0 = 0.f; x1 = 0.f; }
            if (j == 0) { u0 = x0; u1 = x1; }
            s0 += x0; s1 += x1; }
        const int pos = ri.t + 1 + (ri.smp ? 16384 : 0); const float inv = 1.0f / (float)(pos < w ? pos : w);
        *(unsigned*)(PD + ((size_t)g * M + row) * 256 + (c & 255)) = pk2(s0 * inv - u0, s1 * inv - u1);
    }
}

__device__ __forceinline__ float gelu_tanh(float x) { const float u = 0.7978845608028654f * (x + 0.044715f * x * x * x); return 0.5f * x * (1.0f + tanhf(u)); }
__device__ __forceinline__ void lru_scan_unit(Frame& F, int l, int unit) {
    const float* A = (const float*)(F.ws + WS_ALRU); const float* B = (const float*)(F.ws + WS_BLRU); const bf16* P = (const bf16*)(F.ws + WS_P); bf16* OL = (bf16*)(F.ws + WS_OL);
    int row0, len, ch; float h; float* hout;
    if (unit < 8) { const int b = unit >> 1; ch = (unit & 1) * 512 + F.tid; row0 = b * T; len = T; h = 0.f; hout = F.out + O_PLH + ((size_t)l * NB + b) * LW + ch; }
    else { const int q = (unit - 8) * 512 + F.tid, b = q >> 10; ch = q & 1023; row0 = MP + b * ST; len = ST; h = FIN(F, I_SLH)[((size_t)l * SB + b) * LW + ch]; hout = F.out + O_SLH + ((size_t)l * SB + b) * LW + ch; }
    for (int t0 = 0; t0 < len; t0 += 8) {
        float a[8], bt[8], gl[8];
#pragma unroll
        for (int i = 0; i < 8; ++i) { const size_t r = (size_t)(row0 + t0 + i); a[i] = A[r * LW + ch]; bt[i] = B[r * LW + ch]; gl[i] = bf2f(P[r * PW + C_GL + ch]); }
#pragma unroll
        for (int i = 0; i < 8; ++i) { h = a[i] * h + bt[i]; OL[(size_t)(row0 + t0 + i) * LW + ch] = (bf16)(pk2(h * gelu_tanh(gl[i]), 0.f) & 0xffffu); }
    }
    *hout = h;
}
__device__ __forceinline__ void dn_recur_unit(Frame& F, int l, int unit) {
    const float* QN = (const float*)(F.ws + WS_QN); const float* KN = (const float*)(F.ws + WS_KN); const float* VN = (const float*)(F.ws + WS_VN); const float* BG = (const float*)(F.ws + WS_BG);
    const bf16* P = (const bf16*)(F.ws + WS_P); bf16* OD = (bf16*)(F.ws + WS_OD);
    const int tid = F.tid, v = tid & 127, kq = tid >> 7;
    int row0, len, h; const float* s0; float* sout;
    if (unit < 32) { const int b = unit >> 3; h = unit & 7; row0 = b * T; len = T; s0 = nullptr; sout = F.out + O_PDS + (((size_t)l * NB + b) * NH + h) * HD * HD; }
    else { const int q = unit - 32, b = q >> 3; h = q & 7; row0 = MP + b * ST; len = ST; s0 = FIN(F, I_SDS) + (((size_t)l * SB + b) * NH + h) * HD * HD; sout = F.out + O_SDS + (((size_t)l * SB + b) * NH + h) * HD * HD; }
    float S[32];
#pragma unroll
    for (int i = 0; i < 32; ++i) S[i] = s0 ? s0[(size_t)(kq * 32 + i) * HD + v] : 0.f;
    LAS float* vec = (LAS float*)F.lds;
    LAS float* red = vec + 768;
    LAS float* red2 = red + 512;
    LAS float* misc = red2 + 512;
    const float nw = FIN(F, I_DNW)[l * HD + v];
    float pf = 0.f, pbg = 0.f;
    if (tid < 384) { const int s = tid >> 7; const float* src = s == 0 ? KN : (s == 1 ? QN : VN); pf = src[(size_t)row0 * LW + h * 128 + v]; }
    if (tid >= 384 && tid < 386) pbg = BG[(size_t)row0 * 16 + (tid - 384) * 8 + h];
    for (int t = 0; t < len; ++t) {
        const int buf = t & 1; LAS float* vb = vec + buf * 384;
        if (tid < 384) vb[tid] = pf;
        if (tid >= 384 && tid < 386) misc[buf * 2 + (tid - 384)] = pbg;
        if (t + 1 < len) { const size_t r = (size_t)(row0 + t + 1);
            if (tid < 384) { const int s = tid >> 7; const float* src = s == 0 ? KN : (s == 1 ? QN : VN); pf = src[r * LW + h * 128 + v]; }
            if (tid >= 384 && tid < 386) pbg = BG[r * 16 + (tid - 384) * 8 + h]; }
        const float zg = (kq == 0) ? bf2f(P[(size_t)(row0 + t) * PW + C_Z + h * 128 + v]) : 0.f;
        __syncthreads();
        const float beta = misc[buf * 2], alpha = __expf(misc[buf * 2 + 1]);
        float ks = 0.f;
#pragma unroll
        for (int i = 0; i < 32; ++i) ks += vb[kq * 32 + i] * S[i];
        red[kq * 128 + v] = ks;
        __syncthreads();
        const float kS = (red[v] + red[128 + v]) + (red[256 + v] + red[384 + v]);
        const float w = beta * (vb[256 + v] - alpha * kS);
        float os = 0.f;
#pragma unroll
        for (int i = 0; i < 32; ++i) { S[i] = alpha * S[i] + vb[kq * 32 + i] * w; os += vb[128 + kq * 32 + i] * S[i]; }
        red2[kq * 128 + v] = os;
        __syncthreads();
        float o = 0.f;
        if (kq == 0) { o = (red2[v] + red2[128 + v]) + (red2[256 + v] + red2[384 + v]); const float ss = wave_sum(o * o); if (F.lane == 0) misc[4 + F.wave] = ss; }
        __syncthreads();
        if (kq == 0) { const float rstd = 1.0f / sqrtf((misc[4] + misc[5]) * (1.0f / 128.0f) + EPS);
            OD[(size_t)(row0 + t) * LW + h * 128 + v] = (bf16)(pk2(o * rstd * nw * siluf(zg), 0.f) & 0xffffu); }
    }
#pragma unroll
    for (int i = 0; i < 32; ++i) sout[(size_t)(kq * 32 + i) * HD + v] = S[i];
    __syncthreads();
}

constexpr int PH_PER_LAYER = 9;
constexpr int DN_LONG = NB * NH;

#define GRID_BAR() do { if (fused) { XcdBarrier b2_ = bar; unsigned long long bp_ = (unsigned long long)bar.bar; int wv_ = F.wave, ln_; asm volatile("v_mbcnt_lo_u32_b32 %0, -1, 0\n\tv_mbcnt_hi_u32_b32 %0, -1, %0" : "=v"(ln_)); asm volatile("" : "+s"(bp_), "+s"(b2_.x), "+s"(wv_)); b2_.bar = (unsigned*)(GAS unsigned*)bp_; xcd_barrier(b2_, wv_ * 64 + ln_); } } while (0)
#define IN(k) (lo <= (k) && (k) < hi)
#define STR2(x) #x
#define STR(x) STR2(x)
#define ENTER() Frame Fp = F; asm volatile("; PHASE_SITE line " STR(__LINE__)); asm volatile("v_mbcnt_lo_u32_b32 %0, -1, 0\n\tv_mbcnt_hi_u32_b32 %0, -1, %0" : "=v"(Fp.lane)); \
    { unsigned long long ws_ = (unsigned long long)F.ws, out_ = (unsigned long long)F.out; asm volatile("" : "+s"(ws_), "+s"(out_), "+s"(Fp.bx), "+s"(Fp.G), "+s"(Fp.wave)); \
      Fp.ws = (unsigned char*)(GAS unsigned char*)ws_; Fp.out = (float*)(GAS float*)out_; } \
    Fp.tid = Fp.wave * 64 + Fp.lane; Fp.ctl = (gu32*)(GAS unsigned char*)(Fp.ws + WS_CTL)
#define WL(Fp, l) ((const bf16*)((Fp).ws + WS_W) + (size_t)(l) * WL_ELEMS)

template <int l> __device__ __forceinline__ void layer_phases(const Frame& F, const XcdBarrier& bar, const bool fused, const int lo, const int hi) {
        if (IN(0)) { ENTER(); rms_rows_bf16(Fp, (const float*)(Fp.ws + WS_X), FIN(Fp, I_NMIX) + (size_t)l * D, (bf16*)(Fp.ws + WS_XN)); GRID_BAR(); }
        if (IN(1)) {
            ENTER();
            pg8::Gemm g{(const bf16*)(Fp.ws + WS_XN), WL(Fp, l) + WL_IN, M, NINP, D, D, D}; pg8::StaticOrder S; S.init(M, NINP, Fp.G, Fp.bx);
            pg8::EpiInProj E{(bf16*)(Fp.ws + WS_P), (float*)(Fp.ws + WS_BA), PW, PW / 256};
            pg8::gemm_phase<pg8::EpiInProj, pg8::StaticOrder, true, true>(Fp.lds + RING_OFF, g, S, E, Fp.tid);
            GRID_BAR();
        }
        if (IN(2)) {
            ENTER();
            for (int u = Fp.bx; u < (M / 64) * 16; u += Fp.G) lru_gates_unit(Fp, l, u);
            for (int it = Fp.bx * NWAVES + Fp.wave; it < M * NH; it += Fp.G * NWAVES) dn_pre_item(Fp, l, it);
            pool_d_rows(Fp, l);
            state_outputs(Fp, l);
            GRID_BAR();
        }
        if (IN(3)) {
            { ENTER();
              const int c = Fp.bx - DN_LONG, Gr = Fp.G - DN_LONG;
              if (c >= 0) for (int u = c; u < 8 + 256; u += Gr) lru_scan_unit(Fp, l, u);
              for (int u = (c < 0 ? Fp.bx : DN_LONG + c); u < DN_LONG + SB * NH; u += (c < 0 ? (1 << 30) : Gr)) dn_recur_unit(Fp, l, u);
            }
            { ENTER();
              const int c = Fp.bx - DN_LONG, Gr = Fp.G - DN_LONG;
              pg8::Gemm g{(const bf16*)(Fp.ws + WS_PD), WL(Fp, l) + WL_POOL, 4 * M, 256, 256, 256, 256};
              pg8::GroupedOrder S; S.init(4 * M, 256, Gr, c); S.tpg = M / 256; S.bgb = (size_t)256 * 256 * 2;
              pg8::EpiPool E{(bf16*)(Fp.ws + WS_OP), FIN(Fp, I_PSC) + (size_t)l * PLW, LW, M / 256};
              pg8::gemm_phase<pg8::EpiPool, pg8::GroupedOrder, true, true>(Fp.lds + RING_OFF, g, S, E, Fp.tid);
            }
            GRID_BAR();
        }
        if (IN(4)) {
            { ENTER(); pg8::StaticOrder S; S.init(M, D, Fp.G, Fp.bx);
              pg8::Gemm g{(const bf16*)(Fp.ws + WS_OL), WL(Fp, l) + WL_BR, M, D, LW, LW, LW}; pg8::EpiBranch<0> E{(const bf16*)(Fp.ws + WS_P) + C_GLRU, PW, (float*)(Fp.ws + WS_MGF), (bf16*)(Fp.ws + WS_MG), D};
              pg8::gemm_phase<pg8::EpiBranch<0>, pg8::StaticOrder, true, true>(Fp.lds + RING_OFF, g, S, E, Fp.tid); }
            { ENTER(); pg8::StaticOrder S; S.init(M, D, Fp.G, Fp.bx);
              pg8::Gemm g{(const bf16*)(Fp.ws + WS_OD), WL(Fp, l) + WL_BR + (size_t)D * LW, M, D, LW, LW, LW}; pg8::EpiBranch<1> E{(const bf16*)(Fp.ws + WS_P) + C_GDN, PW, (float*)(Fp.ws + WS_MGF), (bf16*)(Fp.ws + WS_MG), D};
              pg8::gemm_phase<pg8::EpiBranch<1>, pg8::StaticOrder, true, true>(Fp.lds + RING_OFF, g, S, E, Fp.tid); }
            { ENTER(); pg8::StaticOrder S; S.init(M, D, Fp.G, Fp.bx);
              pg8::Gemm g{(const bf16*)(Fp.ws + WS_OP), WL(Fp, l) + WL_BR + 2 * (size_t)D * LW, M, D, LW, LW, LW}; pg8::EpiBranch<2> E{(const bf16*)(Fp.ws + WS_P) + C_GPOOL, PW, (float*)(Fp.ws + WS_MGF), (bf16*)(Fp.ws + WS_MG), D};
              pg8::gemm_phase<pg8::EpiBranch<2>, pg8::StaticOrder, true, true>(Fp.lds + RING_OFF, g, S, E, Fp.tid); }
            GRID_BAR();
        }
        if (IN(5)) {
            ENTER();
            pg8::Gemm g{(const bf16*)(Fp.ws + WS_MG), WL(Fp, l) + WL_OUT, M, D, D, D, D}; pg8::StaticOrder S; S.init(M, D, Fp.G, Fp.bx);
            pg8::EpiResid E{(float*)(Fp.ws + WS_X), D};
            pg8::gemm_phase<pg8::EpiResid, pg8::StaticOrder, true, true>(Fp.lds + RING_OFF, g, S, E, Fp.tid);
            GRID_BAR();
        }
        if (IN(6)) { ENTER(); rms_rows_bf16(Fp, (const float*)(Fp.ws + WS_X), FIN(Fp, I_NMLP) + (size_t)l * D, (bf16*)(Fp.ws + WS_XN)); GRID_BAR(); }
        if (IN(7)) {
            ENTER();
            pg8::Gemm g{(const bf16*)(Fp.ws + WS_XN), WL(Fp, l) + WL_UP, M, FF, D, D, D}; pg8::StaticOrder S; S.init(M, FF, Fp.G, Fp.bx);
            pg8::EpiUp E{(bf16*)(Fp.ws + WS_HM), FF};
            pg8::gemm_phase<pg8::EpiUp, pg8::StaticOrder, true, true>(Fp.lds + RING_OFF, g, S, E, Fp.tid);
            GRID_BAR();
        }
        if (IN(8)) {
            ENTER();
            pg8::Gemm g{(const bf16*)(Fp.ws + WS_HM), WL(Fp, l) + WL_DN, M, D, FF, FF, FF}; pg8::StaticOrder S; S.init(M, D, Fp.G, Fp.bx);
            pg8::EpiResid E{(float*)(Fp.ws + WS_X), D};
            pg8::gemm_phase<pg8::EpiResid, pg8::StaticOrder, true, true>(Fp.lds + RING_OFF, g, S, E, Fp.tid);
            GRID_BAR();
        }
}

__global__ void __launch_bounds__(NTHREADS, 2) fwd(Args args) {
    extern __shared__ __attribute__((aligned(16))) unsigned char lds[];
    Frame F;
    F.lds = (LAS unsigned char*)lds;
    F.MISC = (volatile LAS unsigned*)(F.lds + MISC_OFF);
    F.tid = 0; F.lane = 0; F.wave = __builtin_amdgcn_readfirstlane((int)(threadIdx.x >> 6));
    F.G = gridDim.x; F.bx = blockIdx.x;
    F.ka = (const AS4 Args*)__builtin_amdgcn_kernarg_segment_ptr(); F.out = (float*)(GAS float*)args.out; F.ws = (unsigned char*)(GAS unsigned char*)args.ws;
    F.ctl = (gu32*)(GAS unsigned char*)(args.ws + WS_CTL);
    if (threadIdx.x < 64) ((LAS unsigned*)(F.lds + MISC_OFF))[threadIdx.x] = 0u;
    __syncthreads();
    const bool fused = (args.flags & 4) != 0;
    XcdBarrier bar; bar.bar = (unsigned*)(F.ctl + CW_BAR); bar.x = 0; bar.st = nullptr;
    if (fused) bar = xcd_barrier_post((unsigned*)(F.ctl + CW_BAR), F.MISC + 8, (int)threadIdx.x);
    const int lo = args.ph_lo, hi = args.ph_hi;

    if (args.flags & 1) { ENTER(); p0_prologue(Fp); GRID_BAR(); }

    if (args.l_lo <= 0 && 0 < args.l_hi) layer_phases<0>(F, bar, fused, lo, hi);
    if (args.l_lo <= 1 && 1 < args.l_hi) layer_phases<1>(F, bar, fused, lo, hi);
    if (args.l_lo <= 2 && 2 < args.l_hi) layer_phases<2>(F, bar, fused, lo, hi);
    if (args.l_lo <= 3 && 3 < args.l_hi) layer_phases<3>(F, bar, fused, lo, hi);
    if (args.flags & 2) { ENTER(); rms_rows_f32(Fp, (const float*)(Fp.ws + WS_X), FIN(Fp, I_NFIN), Fp.out + O_YP); }
}

#ifndef MK_FUSED
#define MK_FUSED 0
#endif
extern "C" void kernel_launch(void* const* d_in, const int* in_sizes, int n_in, void* d_out, int out_size, void* d_ws, size_t ws_size, hipStream_t stream) {
    static int grid = 0;
    if (grid == 0) {
        if (n_in != N_INPUTS || (size_t)out_size != O_END || ws_size < WS_END) { fprintf(stderr, "kernel_launch: unexpected shapes: n_in %d out %d ws %zu (need %zu)\n", n_in, out_size, ws_size, (size_t)WS_END); grid = -1; return; }
        int dev = 0, cus = 0, per_cu = 0;
        if (hipGetDevice(&dev) != hipSuccess || hipDeviceGetAttribute(&cus, hipDeviceAttributeMultiprocessorCount, dev) != hipSuccess) { grid = -1; return; }
        if (hipFuncSetAttribute((const void*)fwd, hipFuncAttributeMaxDynamicSharedMemorySize, LDS_BYTES) != hipSuccess) { fprintf(stderr, "kernel_launch: hipFuncSetAttribute failed\n"); grid = -1; return; }
        if (hipOccupancyMaxActiveBlocksPerMultiprocessor(&per_cu, (const void*)fwd, NTHREADS, LDS_BYTES) != hipSuccess || per_cu < 1) fprintf(stderr, "kernel_launch: occupancy query says %d\n", per_cu);
        (void)hipGetLastError();
        grid = cus;
    }
    if (grid < 0) return;
    (void)hipMemsetAsync((char*)d_ws + WS_CTL, 0, CTL_ZERO_BYTES, stream);
    Args a{};
    for (int i = 0; i < N_INPUTS; ++i) a.in[i] = (const float*)d_in[i];
    a.out = (float*)d_out; a.ws = (unsigned char*)d_ws;
#define LAUNCH(L0, L1, P0_, P1_, FL) do { a.l_lo = (L0); a.l_hi = (L1); a.ph_lo = (P0_); a.ph_hi = (P1_); a.flags = (FL); hipLaunchKernelGGL(fwd, dim3(grid), dim3(NTHREADS), LDS_BYTES, stream, a); } while (0)
#if MK_FUSED
    LAUNCH(0, DEPTH, 0, PH_PER_LAYER, 1 | 2 | 4);
#else
    LAUNCH(0, 0, 0, 0, 1);
    for (int l = 0; l < DEPTH; ++l)
        for (int p = 0; p < PH_PER_LAYER; ++p) LAUNCH(l, l + 1, p, p + 1, 0);
    LAUNCH(0, 0, 0, 0, 2);
#endif
#undef LAUNCH
}
```

```cpp
#include <hip/hip_runtime.h>
#include <cstdio>
#include <cstdint>

namespace pg8 {
#define PG8_LAS __attribute__((address_space(3)))
typedef unsigned short bf16_t;
typedef short bf16x8 __attribute__((ext_vector_type(8)));
typedef float f32x4 __attribute__((ext_vector_type(4)));
typedef unsigned u32x4 __attribute__((ext_vector_type(4)));
constexpr int BM = 256, BK = 64, HALF = 128, HTB = HALF * BK * 2  , STAGE_BYTES = 8 * HTB, NXCD = 8, WGM = 8;

__host__ __device__ __forceinline__ int lds_byte(int r, int c) { const int st = (r >> 4) * 2 + (c >> 5), rr = r & 15, cc = c & 31, ob = rr * 64 + cc * 2; return st * 1024 + (ob ^ (((ob >> 9) & 1) << 5)); }
__host__ __device__ __forceinline__ void stage_rc(int b, int& R, int& C) { const int st = b / 1024, sb = b % 1024, swz = sb ^ (((sb >> 9) & 1) << 5); R = (st >> 1) * 16 + swz / 64; C = (st & 1) * 32 + (swz % 64) / 2; }
__host__ __device__ __forceinline__ int perm32(int rho) { const int n = rho >> 4, i = rho & 15; return 8 * (i >> 2) + 4 * n + (i & 3); }

struct Unit { int pm, pn, ks; };
struct Gemm { const bf16_t* A; const bf16_t* Bt; int M, N, K, lda, ldb; };

struct StaticOrder {
    int nM, nN, nwg, G, c;
    __host__ __device__ void init(int M, int N, int G_, int c_) { nM = M / BM; nN = N / BM; nwg = nM * nN; G = G_; c = c_; }
    __host__ __device__ bool next(int i, Unit& u) const {
        if (c < 0) return false;
        const long L = (long)i * G + c; if (L >= nwg) return false;
        int wgid = (int)L; { const int q = nwg / NXCD, r = nwg % NXCD, xcd = wgid % NXCD, off = wgid / NXCD; wgid = (xcd < r ? xcd * (q + 1) : r * (q + 1) + (xcd - r) * q) + off; }
        const int nig = WGM * nN, gid = wgid / nig, fm = gid * WGM, gsz = (nM - fm) < WGM ? (nM - fm) : WGM;
        u.pm = fm + ((wgid % nig) % gsz); u.pn = (wgid % nig) / gsz; u.ks = 0; return true;
    }
    __device__ __forceinline__ size_t a_extra(const Unit&) const { return 0; }
    __device__ __forceinline__ size_t b_extra(const Unit&) const { return 0; }
    __device__ __forceinline__ void a_ready(const Unit&) const {}
    __device__ __forceinline__ void done(const Unit&) const {}
};
struct GroupedOrder : StaticOrder {
    int tpg; size_t bgb;
    __device__ __forceinline__ size_t b_extra(const Unit& u) const { return (size_t)(u.pm / tpg) * bgb; }
};
struct SliceOrder {
    int nN, nks, ntot, c, bmod; size_t astride, bstride;
    __device__ void init(int nM_, int nN_, int nks_, size_t astride_, size_t bstride_, int bmod_, int c_) { nN = nN_; nks = nks_; ntot = nM_ * nN_ * nks_; c = c_; astride = astride_; bstride = bstride_; bmod = bmod_; }
    __device__ bool next(int i, Unit& u) const { if (i != 0 || c < 0 || c >= ntot) return false; const int t = c / nks; u.ks = c - t * nks; u.pm = t / nN; u.pn = t - u.pm * nN; return true; }
    __device__ __forceinline__ size_t a_extra(const Unit& u) const { return (size_t)u.ks * astride; }
    __device__ __forceinline__ size_t b_extra(const Unit& u) const { return (size_t)(u.ks % bmod) * bstride; }
    __device__ __forceinline__ void a_ready(const Unit&) const {}
    __device__ __forceinline__ void done(const Unit&) const {}
};

struct BranchOrder : StaticOrder {
    int nbr; size_t astride, bstride;
    __device__ bool next(int i, Unit& u) const { if (i >= nbr || !StaticOrder::next(0, u)) return false; u.ks = i; return true; }
    __device__ __forceinline__ size_t a_extra(const Unit& u) const { return (size_t)u.ks * astride; }
    __device__ __forceinline__ size_t b_extra(const Unit& u) const { return (size_t)u.ks * bstride; }
};

__device__ __forceinline__ unsigned cvt_pk_bf16(float lo, float hi) { unsigned r; asm volatile("v_cvt_pk_bf16_f32 %0, %1, %2" : "=v"(r) : "v"(lo), "v"(hi)); return r; }

template <class Epi, class Sched, bool ALIGN_EPI = false, bool SP2 = false>
__device__ __forceinline__ void gemm_phase(PG8_LAS unsigned char* lds, const Gemm g, const Sched& S, const Epi& E, const int tid) {
    const int wid = __builtin_amdgcn_readfirstlane(tid >> 6), lane = tid & 63, wr = wid >> 2, wc = wid & 3, fr = lane & 15, fq = lane >> 4;
    const int K = g.K, nt = K / BK;
    unsigned voffA[2], voffB[2];
#pragma unroll
    for (int i = 0; i < 2; ++i) { int R, C; stage_rc(tid * 16 + i * 8192, R, C); const int Rb = Epi::PERM ? ((R & ~31) + perm32(R & 31)) : R;
        voffA[i] = (unsigned)(R * g.lda + C) * 2u; voffB[i] = (unsigned)(Rb * g.ldb + C) * 2u; }
    const size_t kstep = (size_t)(BK * 2);
    const size_t hstepA = (size_t)HALF * g.lda * 2, hstepB = (size_t)HALF * g.ldb * 2;
    const size_t tstepA = 2 * hstepA, tstepB = 2 * hstepB;
    const unsigned ldsw = (unsigned)wid * 1024u;
    const int aoff = lds_byte(wr * 64 + fr, fq * 8), boff = lds_byte(wc * 32 + fr, fq * 8);
#define PG8_SA(b, h) (((b) * 2 + (h)) * HTB)
#define PG8_SB(b, h) ((4 + (b) * 2 + (h)) * HTB)
#define PG8_STAGE(bufoff, gbase, voff) do { _Pragma("unroll") for (int _i = 0; _i < 2; ++_i) \
        __builtin_amdgcn_global_load_lds((const unsigned*)((const char*)(gbase) + (voff)[_i]), (PG8_LAS unsigned*)(lds + (bufoff) + ldsw + _i * 8192), 16, 0, 0); } while (0)
#define PG8_LDA(dst, b, h) do { _Pragma("unroll") for (int m = 0; m < 4; ++m) _Pragma("unroll") for (int k = 0; k < 2; ++k) dst[m][k] = *(const PG8_LAS bf16x8*)(lds + PG8_SA(b, h) + aoff + m * 2048 + k * 1024); } while (0)
#define PG8_LDB(dst, b, h) do { _Pragma("unroll") for (int n = 0; n < 2; ++n) _Pragma("unroll") for (int k = 0; k < 2; ++k) dst[n][k] = *(const PG8_LAS bf16x8*)(lds + PG8_SB(b, h) + boff + n * 2048 + k * 1024); } while (0)
#define PG8_MMA(ai, bj, At, Bt) do { __builtin_amdgcn_s_setprio(1); _Pragma("unroll") for (int m = 0; m < 4; ++m) _Pragma("unroll") for (int n = 0; n < 2; ++n) _Pragma("unroll") for (int k = 0; k < 2; ++k) \
        acc[ai][bj][m][n] = __builtin_amdgcn_mfma_f32_16x16x32_bf16(Bt[n][k], At[m][k], acc[ai][bj][m][n], 0, 0, 0); __builtin_amdgcn_s_setprio(0); } while (0)
#define PG8_WAIT_V(n) asm volatile("s_waitcnt vmcnt(" #n ")" ::: "memory")
#define PG8_WAIT_L(n) asm volatile("s_waitcnt lgkmcnt(" #n ")" ::: "memory")
#define PG8_BAR __builtin_amdgcn_s_barrier()
#define PG8_SCHED __builtin_amdgcn_sched_barrier(0)
    Unit cur, nxt; int ui = 0;
    if (!S.next(0, cur)) return;
    f32x4 acc[2][2][4][2];
#pragma unroll
    for (int a = 0; a < 2; ++a)
#pragma unroll
        for (int b = 0; b < 2; ++b)
#pragma unroll
            for (int m = 0; m < 4; ++m)
#pragma unroll
                for (int n = 0; n < 2; ++n) acc[a][b][m][n] = (f32x4){0.f, 0.f, 0.f, 0.f};
    bf16x8 At[4][2], B0[2][2], B1[2][2];
    const char* cA = (const char*)g.A + (size_t)cur.pm * tstepA + S.a_extra(cur); const char* cB = (const char*)g.Bt + (size_t)cur.pn * tstepB + S.b_extra(cur);
    S.a_ready(cur);
    if constexpr (SP2) {
        PG8_STAGE(PG8_SB(0, 0), cB, voffB); PG8_STAGE(PG8_SB(0, 1), cB + hstepB, voffB); PG8_STAGE(PG8_SA(0, 0), cA, voffA); PG8_STAGE(PG8_SA(0, 1), cA + hstepA, voffA);
        if (wr == 1) PG8_BAR;
        PG8_WAIT_V(2); PG8_BAR;
        PG8_STAGE(PG8_SB(1, 0), cB + kstep, voffB); PG8_STAGE(PG8_SA(1, 0), cA + kstep, voffA); PG8_STAGE(PG8_SB(1, 1), cB + hstepB + kstep, voffB);
        PG8_WAIT_V(6); PG8_BAR;
    } else {
        PG8_STAGE(PG8_SB(0, 0), cB, voffB); PG8_STAGE(PG8_SA(0, 0), cA, voffA); PG8_STAGE(PG8_SB(0, 1), cB + hstepB, voffB); PG8_STAGE(PG8_SA(0, 1), cA + hstepA, voffA);
        if (wr == 1) PG8_BAR;
        PG8_WAIT_V(4); PG8_BAR;
        PG8_STAGE(PG8_SB(1, 0), cB + kstep, voffB); PG8_STAGE(PG8_SA(1, 0), cA + kstep, voffA); PG8_STAGE(PG8_SB(1, 1), cB + hstepB + kstep, voffB);
        PG8_WAIT_V(6); PG8_BAR;
    }
    for (;;) {
        const bool has_next = S.next(ui + 1, nxt);
        const char* nA = has_next ? (const char*)g.A + (size_t)nxt.pm * tstepA + S.a_extra(nxt) : cA; const char* nB = has_next ? (const char*)g.Bt + (size_t)nxt.pn * tstepB + S.b_extra(nxt) : cB;
        for (int t = 0; t < nt; t += 2) {
            const bool last = (t == nt - 2);
            const char* a1 = cA + (size_t)(t + 1) * kstep;
            const char* a2 = last ? nA : cA + (size_t)(t + 2) * kstep; const char* b2 = last ? nB : cB + (size_t)(t + 2) * kstep;
            const char* a3 = a2 + kstep; const char* b3 = b2 + kstep;
            if (last && has_next) S.a_ready(nxt);
            if constexpr (SP2) {
            PG8_LDB(B0, 0, 0); PG8_LDB(B1, 0, 1); PG8_SCHED; PG8_LDA(At, 0, 0); PG8_STAGE(PG8_SA(1, 1), a1 + hstepA, voffA);
            PG8_WAIT_V(8); PG8_WAIT_L(0); PG8_BAR; PG8_MMA(0, 0, At, B0); PG8_MMA(0, 1, At, B1); PG8_BAR; PG8_SCHED;
            PG8_LDA(At, 0, 1); PG8_STAGE(PG8_SB(0, 0), b2, voffB); PG8_STAGE(PG8_SB(0, 1), b2 + hstepB, voffB); PG8_STAGE(PG8_SA(0, 0), a2, voffA);
            PG8_WAIT_V(8); PG8_WAIT_L(0); PG8_BAR; PG8_MMA(1, 0, At, B0); PG8_MMA(1, 1, At, B1); PG8_BAR; PG8_SCHED;
            PG8_LDB(B0, 1, 0); PG8_LDB(B1, 1, 1); PG8_SCHED; PG8_LDA(At, 1, 0); PG8_STAGE(PG8_SA(0, 1), a2 + hstepA, voffA);
            PG8_WAIT_V(8); PG8_WAIT_L(0); PG8_BAR; PG8_MMA(0, 0, At, B0); PG8_MMA(0, 1, At, B1); PG8_BAR; PG8_SCHED;
            PG8_LDA(At, 1, 1); PG8_STAGE(PG8_SB(1, 0), b3, voffB); PG8_STAGE(PG8_SB(1, 1), b3 + hstepB, voffB); PG8_STAGE(PG8_SA(1, 0), a3, voffA);
            PG8_WAIT_V(8); PG8_WAIT_L(0); PG8_BAR; PG8_MMA(1, 0, At, B0); PG8_MMA(1, 1, At, B1); PG8_BAR; PG8_SCHED;
            } else {
            PG8_LDB(B0, 0, 0); PG8_SCHED; PG8_LDA(At, 0, 0); PG8_STAGE(PG8_SA(1, 1), a1 + hstepA, voffA);
            PG8_WAIT_L(8); PG8_BAR; PG8_WAIT_L(0); PG8_MMA(0, 0, At, B0); PG8_BAR; PG8_SCHED;
            PG8_LDB(B1, 0, 1); PG8_STAGE(PG8_SB(0, 0), b2, voffB);
            PG8_BAR; PG8_WAIT_L(0); PG8_MMA(0, 1, At, B1); PG8_BAR;
            PG8_LDA(At, 0, 1); PG8_STAGE(PG8_SA(0, 0), a2, voffA);
            PG8_BAR; PG8_WAIT_L(0); PG8_MMA(1, 0, At, B0); PG8_BAR; PG8_SCHED;
            PG8_STAGE(PG8_SB(0, 1), b2 + hstepB, voffB);
            PG8_WAIT_V(6); PG8_BAR; PG8_MMA(1, 1, At, B1); PG8_BAR;
            PG8_LDB(B0, 1, 0); PG8_SCHED; PG8_LDA(At, 1, 0); PG8_STAGE(PG8_SA(0, 1), a2 + hstepA, voffA);
            PG8_WAIT_L(8); PG8_BAR; PG8_WAIT_L(0); PG8_MMA(0, 0, At, B0); PG8_BAR; PG8_SCHED;
            PG8_LDB(B1, 1, 1); PG8_STAGE(PG8_SB(1, 0), b3, voffB);
            PG8_BAR; PG8_WAIT_L(0); PG8_MMA(0, 1, At, B1); PG8_BAR;
            PG8_LDA(At, 1, 1); PG8_STAGE(PG8_SA(1, 0), a3, voffA);
            PG8_BAR; PG8_WAIT_L(0); PG8_MMA(1, 0, At, B0); PG8_BAR; PG8_SCHED;
            PG8_STAGE(PG8_SB(1, 1), b3 + hstepB, voffB);
            PG8_WAIT_V(6); PG8_BAR; PG8_MMA(1, 1, At, B1); PG8_BAR;
            }
        }
        if constexpr (ALIGN_EPI) { if (wr == 0) PG8_BAR; }
        if constexpr (!Epi::AFTER_DRAIN) { int ln_; asm volatile("v_mbcnt_lo_u32_b32 %0, -1, 0\n\tv_mbcnt_hi_u32_b32 %0, -1, %0" : "=v"(ln_));
            E(acc, cur, wr, wc, ln_ & 15, ln_ >> 4); S.done(cur); }
        if (!has_next) break;
#pragma unroll
        for (int a = 0; a < 2; ++a)
#pragma unroll
            for (int b = 0; b < 2; ++b)
#pragma unroll
                for (int m = 0; m < 4; ++m)
#pragma unroll
                    for (int n = 0; n < 2; ++n) acc[a][b][m][n] = (f32x4){0.f, 0.f, 0.f, 0.f};
        cur = nxt; cA = nA; cB = nB; ++ui;
        if constexpr (ALIGN_EPI) { if (wr == 1) PG8_BAR; }
    }
    PG8_WAIT_V(0);
    if constexpr (!ALIGN_EPI) { if (wr == 0) PG8_BAR; }
    PG8_BAR;
    if constexpr (Epi::AFTER_DRAIN) { E.fused(acc, cur, wr, wc, fr, fq, lds, wid, lane); S.done(cur); }
#undef PG8_SA
#undef PG8_SB
#undef PG8_STAGE
#undef PG8_LDA
#undef PG8_LDB
#undef PG8_MMA
#undef PG8_WAIT_V
#undef PG8_WAIT_L
#undef PG8_BAR
#undef PG8_SCHED
}

__device__ __forceinline__ float bf_lo(unsigned w) { return __uint_as_float(w << 16); }
__device__ __forceinline__ float bf_hi(unsigned w) { return __uint_as_float(w & 0xffff0000u); }
__device__ __forceinline__ float sigmoidf_fast(float x) { return __builtin_amdgcn_rcpf(1.0f + __expf(-x)); }
__device__ __forceinline__ u32x4 pack8(const f32x4 a, const f32x4 b) { u32x4 w; w.x = cvt_pk_bf16(a[0], a[1]); w.y = cvt_pk_bf16(a[2], a[3]); w.z = cvt_pk_bf16(b[0], b[1]); w.w = cvt_pk_bf16(b[2], b[3]); return w; }

struct EpiInProj {
    static constexpr bool PERM = true, AFTER_DRAIN = false;
    bf16_t* P; float* BA; int ldp; int npn;
    __device__ __forceinline__ void operator()(const f32x4 (&acc)[2][2][4][2], const Unit& u, int wr, int wc, int fr, int fq) const {
        const int row0 = u.pm * BM + wr * 64 + fr;
        if (u.pn < npn) {
            const int col0 = u.pn * BM + wc * 32 + 8 * fq;
#pragma unroll
            for (int ai = 0; ai < 2; ++ai)
#pragma unroll
                for (int m = 0; m < 4; ++m) { bf16_t* rowp = P + (size_t)(row0 + ai * HALF + m * 16) * ldp + col0;
#pragma unroll
                    for (int bj = 0; bj < 2; ++bj) *(u32x4*)(rowp + bj * HALF) = pack8(acc[ai][bj][m][0], acc[ai][bj][m][1]); }
        } else if (wc == 0 && fq < 2) {
#pragma unroll
            for (int ai = 0; ai < 2; ++ai)
#pragma unroll
                for (int m = 0; m < 4; ++m) { float* rp = BA + (size_t)(row0 + ai * HALF + m * 16) * 16 + 8 * fq;
                    *(f32x4*)rp = acc[ai][0][m][0]; *(f32x4*)(rp + 4) = acc[ai][0][m][1]; }
        }
    }
};
template <int MODE> struct EpiBranch {
    static constexpr bool PERM = true, AFTER_DRAIN = false;
    const bf16_t* G; int ldg; float* MGf; bf16_t* MG; int ldc;
    __device__ __forceinline__ void operator()(const f32x4 (&acc)[2][2][4][2], const Unit& u, int wr, int wc, int fr, int fq) const {
        const int row0 = u.pm * BM + wr * 64 + fr, col0 = u.pn * BM + wc * 32 + 8 * fq;
#pragma unroll
        for (int ai = 0; ai < 2; ++ai)
#pragma unroll
            for (int m = 0; m < 4; ++m) { const size_t row = (size_t)(row0 + ai * HALF + m * 16);
#pragma unroll
                for (int bj = 0; bj < 2; ++bj) { const int col = col0 + bj * HALF;
                    const u32x4 gw = *(const u32x4*)(G + row * ldg + col);
                    f32x4 s0, s1; s0[0] = sigmoidf_fast(bf_lo(gw.x)); s0[1] = sigmoidf_fast(bf_hi(gw.x)); s0[2] = sigmoidf_fast(bf_lo(gw.y)); s0[3] = sigmoidf_fast(bf_hi(gw.y));
                    s1[0] = sigmoidf_fast(bf_lo(gw.z)); s1[1] = sigmoidf_fast(bf_hi(gw.z)); s1[2] = sigmoidf_fast(bf_lo(gw.w)); s1[3] = sigmoidf_fast(bf_hi(gw.w));
                    f32x4 v0 = acc[ai][bj][m][0] * s0, v1 = acc[ai][bj][m][1] * s1;
                    float* mp = MGf + row * ldc + col;
                    if (MODE >= 1) { v0 = v0 + *(const f32x4*)mp; v1 = v1 + *(const f32x4*)(mp + 4); }
                    if (MODE <= 1) { *(f32x4*)mp = v0; *(f32x4*)(mp + 4) = v1; }
                    else *(u32x4*)(MG + row * ldc + col) = pack8(v0, v1); } }
    }
};
struct EpiBranchAcc {
    static constexpr bool PERM = true, AFTER_DRAIN = false;
    const bf16_t* G; int ldg; bf16_t* MG; int ldc;
    __device__ __forceinline__ void operator()(const f32x4 (&acc)[2][2][4][2], const Unit& u, int wr, int wc, int fr, int fq) const {
        const int row0 = u.pm * BM + wr * 64 + fr, col0 = u.pn * BM + wc * 32 + 8 * fq; const bf16_t* Gb = G + u.ks * 2048;
#pragma unroll
        for (int ai = 0; ai < 2; ++ai)
#pragma unroll
            for (int m = 0; m < 4; ++m) { const size_t row = (size_t)(row0 + ai * HALF + m * 16);
#pragma unroll
                for (int bj = 0; bj < 2; ++bj) { const int col = col0 + bj * HALF;
                    const u32x4 gw = *(const u32x4*)(Gb + row * ldg + col);
                    f32x4 s0, s1; s0[0] = sigmoidf_fast(bf_lo(gw.x)); s0[1] = sigmoidf_fast(bf_hi(gw.x)); s0[2] = sigmoidf_fast(bf_lo(gw.y)); s0[3] = sigmoidf_fast(bf_hi(gw.y));
                    s1[0] = sigmoidf_fast(bf_lo(gw.z)); s1[1] = sigmoidf_fast(bf_hi(gw.z)); s1[2] = sigmoidf_fast(bf_lo(gw.w)); s1[3] = sigmoidf_fast(bf_hi(gw.w));
                    f32x4 v0 = acc[ai][bj][m][0] * s0, v1 = acc[ai][bj][m][1] * s1;
                    bf16_t* mp = MG + row * ldc + col;
                    if (u.ks > 0) { const u32x4 pw = *(const u32x4*)mp;
                        v0 = v0 + (f32x4){bf_lo(pw.x), bf_hi(pw.x), bf_lo(pw.y), bf_hi(pw.y)}; v1 = v1 + (f32x4){bf_lo(pw.z), bf_hi(pw.z), bf_lo(pw.w), bf_hi(pw.w)}; }
                    *(u32x4*)mp = pack8(v0, v1); } }
    }
};
struct EpiBranchS {
    static constexpr bool PERM = true, AFTER_DRAIN = false;
    const bf16_t* G; int ldg; bf16_t* O; int ldo;
    __device__ __forceinline__ void operator()(const f32x4 (&acc)[2][2][4][2], const Unit& u, int wr, int wc, int fr, int fq) const {
        const int row0 = u.pm * BM + wr * 64 + fr, col0 = u.ks * 2048 + u.pn * BM + wc * 32 + 8 * fq;
#pragma unroll
        for (int ai = 0; ai < 2; ++ai)
#pragma unroll
            for (int m = 0; m < 4; ++m) { const size_t row = (size_t)(row0 + ai * HALF + m * 16);
#pragma unroll
                for (int bj = 0; bj < 2; ++bj) { const int col = col0 + bj * HALF;
                    const u32x4 gw = *(const u32x4*)(G + row * ldg + col);
                    f32x4 s0, s1; s0[0] = sigmoidf_fast(bf_lo(gw.x)); s0[1] = sigmoidf_fast(bf_hi(gw.x)); s0[2] = sigmoidf_fast(bf_lo(gw.y)); s0[3] = sigmoidf_fast(bf_hi(gw.y));
                    s1[0] = sigmoidf_fast(bf_lo(gw.z)); s1[1] = sigmoidf_fast(bf_hi(gw.z)); s1[2] = sigmoidf_fast(bf_lo(gw.w)); s1[3] = sigmoidf_fast(bf_hi(gw.w));
                    *(u32x4*)(O + row * ldo + col) = pack8(acc[ai][bj][m][0] * s0, acc[ai][bj][m][1] * s1); } }
    }
};
struct EpiResid {
    static constexpr bool PERM = true, AFTER_DRAIN = false;
    float* X; int ldc;
    __device__ __forceinline__ void operator()(const f32x4 (&acc)[2][2][4][2], const Unit& u, int wr, int wc, int fr, int fq) const {
        const int row0 = u.pm * BM + wr * 64 + fr, col0 = u.pn * BM + wc * 32 + 8 * fq;
#pragma unroll
        for (int ai = 0; ai < 2; ++ai)
#pragma unroll
            for (int m = 0; m < 4; ++m) { float* rowp = X + (size_t)(row0 + ai * HALF + m * 16) * ldc + col0;
#pragma unroll
                for (int bj = 0; bj < 2; ++bj) { float* p = rowp + bj * HALF;
                    const f32x4 a = *(const f32x4*)p, b = *(const f32x4*)(p + 4);
                    *(f32x4*)p = a + acc[ai][bj][m][0]; *(f32x4*)(p + 4) = b + acc[ai][bj][m][1]; } }
    }
};
struct EpiSlab {
    static constexpr bool PERM = true, AFTER_DRAIN = false;
    bf16_t* S; int ldc; size_t slab_elems;
    __device__ __forceinline__ void operator()(const f32x4 (&acc)[2][2][4][2], const Unit& u, int wr, int wc, int fr, int fq) const {
        const int row0 = u.pm * BM + wr * 64 + fr, col0 = u.pn * BM + wc * 32 + 8 * fq; bf16_t* base = S + (size_t)u.ks * slab_elems;
#pragma unroll
        for (int ai = 0; ai < 2; ++ai)
#pragma unroll
            for (int m = 0; m < 4; ++m) { bf16_t* rowp = base + (size_t)(row0 + ai * HALF + m * 16) * ldc + col0;
#pragma unroll
                for (int bj = 0; bj < 2; ++bj) { const f32x4 a0 = acc[ai][bj][m][0], a1 = acc[ai][bj][m][1]; u32x4 o; o.x = cvt_pk_bf16(a0[0], a0[1]); o.y = cvt_pk_bf16(a0[2], a0[3]); o.z = cvt_pk_bf16(a1[0], a1[1]); o.w = cvt_pk_bf16(a1[2], a1[3]);
                    *(u32x4*)(rowp + bj * HALF) = o; } }
    }
};
struct EpiUp {
    static constexpr bool PERM = true, AFTER_DRAIN = false;
    bf16_t* H; int ldc;
    __device__ __forceinline__ void operator()(const f32x4 (&acc)[2][2][4][2], const Unit& u, int wr, int wc, int fr, int fq) const {
        const int row0 = u.pm * BM + wr * 64 + fr, col0 = u.pn * BM + wc * 32 + 8 * fq;
#pragma unroll
        for (int ai = 0; ai < 2; ++ai)
#pragma unroll
            for (int m = 0; m < 4; ++m) { bf16_t* rowp = H + (size_t)(row0 + ai * HALF + m * 16) * ldc + col0;
#pragma unroll
                for (int bj = 0; bj < 2; ++bj) { f32x4 a = acc[ai][bj][m][0], b = acc[ai][bj][m][1];
#pragma unroll
                    for (int j = 0; j < 4; ++j) { const float x = a[j] > 0.f ? a[j] : 0.f, y = b[j] > 0.f ? b[j] : 0.f; a[j] = x * x; b[j] = y * y; }
                    *(u32x4*)(rowp + bj * HALF) = pack8(a, b); } }
    }
};
struct EpiPool {
    static constexpr bool PERM = true, AFTER_DRAIN = false;
    bf16_t* O; const float* scale; int ldc; int tpg;
    __device__ __forceinline__ void operator()(const f32x4 (&acc)[2][2][4][2], const Unit& u, int wr, int wc, int fr, int fq) const {
        const int g = u.pm / tpg, rt = u.pm - g * tpg;
        const int row0 = rt * BM + wr * 64 + fr, col0 = g * BM + wc * 32 + 8 * fq;
#pragma unroll
        for (int bj = 0; bj < 2; ++bj) { const f32x4 sc0 = *(const f32x4*)(scale + col0 + bj * HALF), sc1 = *(const f32x4*)(scale + col0 + bj * HALF + 4);
#pragma unroll
            for (int ai = 0; ai < 2; ++ai)
#pragma unroll
                for (int m = 0; m < 4; ++m) { bf16_t* rowp = O + (size_t)(row0 + ai * HALF + m * 16) * ldc + col0 + bj * HALF;
                    *(u32x4*)rowp = pack8(acc[ai][bj][m][0] * sc0, acc[ai][bj][m][1] * sc1); } }
    }
};
}

constexpr int NWAVES = 8, NTHREADS = NWAVES * 64;
constexpr int D = 2048, NB = 4, T = 2048, DEPTH = 4, SB = 128, ST = 8;
constexpr int MP = NB * T, MS = SB * ST, M = MP + MS;
constexpr int LW = 1024, NH = 8, HD = 128, QKVW = 3072, PLW = 1024, PBUF = 15, FF = 8192;
constexpr int NIN = 13328, NINP = 13568, PW = 13312;
constexpr int C_XL = 0, C_GL = 1024, C_Q = 2048, C_K = 3072, C_V = 4096, C_Z = 5120, C_POOL = 6144, C_GLRU = 7168, C_GDN = 9216, C_GPOOL = 11264;
constexpr float EPS = 1e-6f;
static_assert(M % 256 == 0 && PW % 256 == 0 && NINP % 256 == 0, "tiles");

enum { I_XP = 0, I_XS, I_SLH, I_SLC, I_SDS, I_SDC, I_SPL, I_NMIX, I_WIN, I_LCW, I_LCB, I_LAW, I_LAB, I_LXW, I_LXB, I_LLAM, I_DCW, I_DALOG, I_DDT, I_DNW, I_PW, I_PSC,
       I_WBL, I_WBD, I_WBP, I_WOUT, I_NMLP, I_WUP, I_WDN, I_NFIN, N_INPUTS };
constexpr size_t O_YP = 0, O_YS = O_YP + (size_t)MP * D, O_PLH = O_YS + (size_t)MS * D, O_PLC = O_PLH + (size_t)DEPTH * NB * LW, O_PDS = O_PLC + (size_t)DEPTH * NB * 3 * LW,
                 O_PDC = O_PDS + (size_t)DEPTH * NB * NH * HD * HD, O_PPL = O_PDC + (size_t)DEPTH * NB * 3 * QKVW, O_SLH = O_PPL + (size_t)DEPTH * NB * PBUF * PLW,
                 O_SLC = O_SLH + (size_t)DEPTH * SB * LW, O_SDS = O_SLC + (size_t)DEPTH * SB * 3 * LW, O_SDC = O_SDS + (size_t)DEPTH * SB * NH * HD * HD,
                 O_SPL = O_SDC + (size_t)DEPTH * SB * 3 * QKVW, O_END = O_SPL + (size_t)DEPTH * SB * PBUF * PLW;

#define AS4 __attribute__((address_space(4)))
struct Args { const float* in[N_INPUTS]; float* out; unsigned char* ws; int l_lo, l_hi, ph_lo, ph_hi, flags, pad; };
static_assert(sizeof(Args) == N_INPUTS * 8 + 16 + 24, "Args has no padding");

typedef unsigned short bf16;
constexpr size_t MiB = 1u << 20;
constexpr size_t WS_CTL = 0, CTL_ZERO_BYTES = 1 * MiB;
constexpr size_t WL_IN = 0, WL_BR = WL_IN + (size_t)NINP * D, WL_OUT = WL_BR + 3 * (size_t)D * LW, WL_UP = WL_OUT + (size_t)D * D, WL_DN = WL_UP + (size_t)FF * D,
                 WL_POOL = WL_DN + (size_t)D * FF, WL_ELEMS = WL_POOL + 4 * 256 * 256;
constexpr size_t WS_W = 1 * MiB, WS_W_END = WS_W + DEPTH * WL_ELEMS * 2;
constexpr size_t al256(size_t x) { return (x + 255) & ~(size_t)255; }
constexpr size_t WS_X = al256(WS_W_END);
constexpr size_t WS_XN = WS_X + (size_t)M * D * 4;
constexpr size_t WS_P = WS_XN + (size_t)M * D * 2;
constexpr size_t WS_HM = WS_P;
constexpr size_t WS_BA = WS_P + (size_t)M * PW * 2;
constexpr size_t WS_OL = WS_BA + (size_t)M * 16 * 4;
constexpr size_t WS_OD = WS_OL + (size_t)M * LW * 2;
constexpr size_t WS_OP = WS_OD + (size_t)M * LW * 2;
constexpr size_t WS_PD = WS_OP + (size_t)M * LW * 2;
constexpr size_t WS_MGF = WS_PD + (size_t)M * LW * 2;
constexpr size_t WS_MG = WS_MGF + (size_t)M * D * 4;
constexpr size_t WS_DNP = WS_MG + (size_t)M * D * 2;
constexpr size_t DNP_BLOB = 81920;
constexpr size_t WS_DNP_END = al256(WS_DNP + (size_t)NB * NH * (T / 64) * DNP_BLOB);
constexpr size_t WS_ALRU = WS_DNP_END;
constexpr size_t WS_MGS = WS_ALRU;
constexpr size_t WS_BLRU = WS_ALRU + (size_t)M * LW * 4;
constexpr size_t WS_QN = WS_BLRU + (size_t)M * LW * 4;
constexpr size_t WS_KN = WS_QN + (size_t)M * LW * 4;
constexpr size_t WS_VN = WS_KN + (size_t)M * LW * 4;
constexpr size_t WS_BG = WS_VN + (size_t)M * LW * 4;
constexpr size_t WS_END = WS_BG + (size_t)M * 16 * 4;
static_assert((size_t)M * FF * 2 <= (size_t)M * PW * 2, "HM fits inside P");
static_assert(WS_X % 256 == 0 && WS_XN % 256 == 0 && WS_P % 256 == 0 && WS_BA % 256 == 0 && WS_OL % 256 == 0 && WS_PD % 256 == 0 && WS_MGF % 256 == 0 && WS_MG % 256 == 0 && WS_DNP % 256 == 0, "ws alignment");

constexpr int CW_TMO = 0, CW_CODE = 1;
constexpr int CW_BAR = 4096;
constexpr int CW_QUEUE = 16384;

constexpr int RING_OFF = 0, RING_BYTES = 131072;
constexpr int LDS_BYTES = 160 * 1024;
constexpr int MISC_OFF = LDS_BYTES - 256;

#define GAS __attribute__((address_space(1)))
#define LAS __attribute__((address_space(3)))
typedef unsigned v4u __attribute__((ext_vector_type(4)));
typedef unsigned v2u __attribute__((ext_vector_type(2)));
typedef float f32x4 __attribute__((ext_vector_type(4)));
typedef float f32x2 __attribute__((ext_vector_type(2)));
typedef float f32x16 __attribute__((ext_vector_type(16)));
typedef short bf16x8 __attribute__((ext_vector_type(8)));
typedef GAS unsigned gu32;
#define RLX_AGENT __ATOMIC_RELAXED, __HIP_MEMORY_SCOPE_AGENT
#define LDS_WAIT() asm volatile("s_waitcnt lgkmcnt(0)" ::: "memory")
#define VM_WAIT() asm volatile("s_waitcnt vmcnt(0)" ::: "memory")
typedef __bf16 bf16x2_t __attribute__((ext_vector_type(2)));
__device__ __forceinline__ unsigned pk2(float lo, float hi) { f32x2 v = {lo, hi}; bf16x2_t b = __builtin_convertvector(v, bf16x2_t); return __builtin_bit_cast(unsigned, b); }
__device__ __forceinline__ float bflo(unsigned w) { return __uint_as_float(w << 16); }
__device__ __forceinline__ float bfhi(unsigned w) { return __uint_as_float(w & 0xffff0000u); }
__device__ __forceinline__ float bf2f(bf16 h) { return __uint_as_float(((unsigned)h) << 16); }
__device__ __forceinline__ float sigm(float x) { return __builtin_amdgcn_rcpf(1.0f + __expf(-x)); }
__device__ __forceinline__ float siluf(float x) { return x * __builtin_amdgcn_rcpf(1.0f + __expf(-x)); }
__device__ __forceinline__ float softplusf(float x) { return x > 20.f ? x : log1pf(__expf(x)); }
__device__ __forceinline__ float wave_sum(float v) {
#pragma unroll
    for (int o = 1; o < 64; o <<= 1) v += __shfl_xor(v, o);
    return v;
}
#define XB_TMO      128
#define XB_XCNT(j)  (256  + 64 * (j))
#define XB_XSUB(j)  (1280 + 64 * (j))
#define XB_XGEN(j)  (2304 + 64 * (j))
#define XB_TOP      3328
#define XB_TOPGEN   3392
#define XCD_BAR_WORDS 3456
#define XB_SPIN_CAP (1u << 18)

__device__ __forceinline__ unsigned xb_ld(unsigned* p)              { return __hip_atomic_load(p, __ATOMIC_RELAXED, __HIP_MEMORY_SCOPE_AGENT); }
__device__ __forceinline__ unsigned xb_add(unsigned* p, unsigned v) { return __hip_atomic_fetch_add(p, v, __ATOMIC_RELAXED, __HIP_MEMORY_SCOPE_AGENT); }
__device__ __forceinline__ unsigned xb_xcc_id() { return (unsigned)__builtin_amdgcn_s_getreg((3 << 11) | 20) & 0xFu; }
#define XB_SPIN(cond, bar) do { unsigned _sp = 0; while (cond) { __builtin_amdgcn_s_sleep(1); \
    if ((++_sp & 255u) == 0u) { if (xb_ld(&(bar)[XB_TMO])) break; if (_sp > XB_SPIN_CAP) { atomicAdd(&(bar)[XB_TMO], 1u); break; } } } } while (0)

struct XcdBarrier {
    unsigned* bar; unsigned x;
    volatile LAS unsigned* st;
};

__device__ __forceinline__ XcdBarrier xcd_barrier_post(unsigned* bar, volatile LAS unsigned* st, const int xb_tid) {
    XcdBarrier b; b.bar = bar; b.x = xb_xcc_id(); b.st = st;
    if (xb_tid == 0) (void)xb_add(&bar[XB_XCNT(b.x)], 1u);
    return b;
}
__device__ __forceinline__ void xcd_barrier_complete(unsigned* bar, unsigned x, unsigned& nloc, unsigned& nx) {
    const unsigned G = gridDim.x * gridDim.y * gridDim.z;
    unsigned sum, cnt, mine, sp = 0u;
    for (;;) {
        sum = 0u; cnt = 0u; mine = 0u;
#pragma unroll
        for (unsigned j = 0; j < 16; ++j) { const unsigned c = xb_ld(&bar[XB_XCNT(j)]); sum += c; cnt += (c > 0u) ? 1u : 0u; mine = (j == x) ? c : mine; }
        if (sum == G) break;
        __builtin_amdgcn_s_sleep(1);
        if ((++sp & 255u) == 0u) { if (xb_ld(&bar[XB_TMO])) break; if (sp > XB_SPIN_CAP) { atomicAdd(&bar[XB_TMO], 1u); break; } }
    }
    nloc = mine > 0u ? mine : 1u; nx = cnt > 0u ? cnt : 1u;
}

__device__ __forceinline__ void xcd_barrier(const XcdBarrier& b, const int xb_tid) {
    asm volatile("s_waitcnt vmcnt(0)" ::: "memory");
    __syncthreads();
    if (xb_tid == 0) {
        unsigned* bar = b.bar;
        __builtin_amdgcn_s_waitcnt(0);
        unsigned nloc = b.st[0], nx = b.st[1];
        if (nloc == 0u) { xcd_barrier_complete(bar, b.x, nloc, nx); b.st[0] = nloc; b.st[1] = nx; }
        const unsigned old = xb_add(&bar[XB_XSUB(b.x)], 1u);
        const unsigned gen = old / nloc;
        if (old + 1u == (gen + 1u) * nloc) {
            __builtin_amdgcn_fence(__ATOMIC_RELEASE, "agent");
            asm volatile("s_waitcnt vmcnt(0)" ::: "memory");
            const unsigned og = xb_add(&bar[XB_TOP], 1u);
            const unsigned tg = og / nx;
            if (og + 1u == (tg + 1u) * nx) xb_add(&bar[XB_TOPGEN], 1u);
            else XB_SPIN(xb_ld(&bar[XB_TOPGEN]) == tg, bar);
            __builtin_amdgcn_fence(__ATOMIC_ACQUIRE, "agent");
            xb_add(&bar[XB_XGEN(b.x)], 1u);
            asm volatile("s_waitcnt vmcnt(0)" ::: "memory");
        } else {
            XB_SPIN(xb_ld(&bar[XB_XGEN(b.x)]) == gen, bar);
            __builtin_amdgcn_fence(__ATOMIC_ACQUIRE, "agent");
            asm volatile("s_waitcnt vmcnt(0)" ::: "memory");
        }
    }
    __syncthreads();
}

struct Frame {
    LAS unsigned char* lds;
    volatile LAS unsigned* MISC;
    gu32* ctl;
    int tid, lane, wave;
    int G, bx;
    const AS4 Args* ka;
    float* out; unsigned char* ws;
};
__device__ __forceinline__ LAS unsigned char* lds_opaque(const Frame& F) { unsigned z = 0; asm volatile("" : "+v"(z)); return F.lds + z; }
#define FIN(F, k) ((const float*)(const GAS float*)((F).ka->in[(k)]))

constexpr int TP_PITCH = 516;
constexpr int TP_TILE_BYTES = 64 * TP_PITCH;
constexpr int U_IN = (NINP / 256) * 4, U_BR = 8 * 2, U_OUT = 8 * 4, U_UP = 32 * 4, U_DN = 8 * 16, U_POOL = 4;
constexpr int UNITS_LAYER = U_IN + 3 * U_BR + U_OUT + U_UP + U_DN + U_POOL;
struct TileDesc { const float* W; bf16* Bt; int ldw, K, k0, n0, remap, ntk; };
__device__ __forceinline__ TileDesc p0_unit(Frame& F, const int l, int r) {
    TileDesc d;
    bf16* wl = (bf16*)(F.ws + WS_W) + (size_t)l * WL_ELEMS; d.remap = 0; d.ntk = 8;
    if (r < U_IN) { d.W = FIN(F, I_WIN) + (size_t)l * D * NIN; d.ldw = NIN; d.K = D; d.Bt = wl + WL_IN; d.n0 = 256 * (r >> 2); d.k0 = 512 * (r & 3); d.remap = 1; return d; }
    r -= U_IN;
    if (r < 3 * U_BR) { const int b = r / U_BR, rr = r - b * U_BR; const float* src = b == 0 ? FIN(F, I_WBL) : (b == 1 ? FIN(F, I_WBD) : FIN(F, I_WBP));
        d.W = src + (size_t)l * LW * D; d.ldw = D; d.K = LW; d.Bt = wl + WL_BR + (size_t)b * D * LW; d.n0 = 256 * (rr >> 1); d.k0 = 512 * (rr & 1); return d; }
    r -= 3 * U_BR;
    if (r < U_OUT) { d.W = FIN(F, I_WOUT) + (size_t)l * D * D; d.ldw = D; d.K = D; d.Bt = wl + WL_OUT; d.n0 = 256 * (r >> 2); d.k0 = 512 * (r & 3); return d; }
    r -= U_OUT;
    if (r < U_UP) { d.W = FIN(F, I_WUP) + (size_t)l * D * FF; d.ldw = FF; d.K = D; d.Bt = wl + WL_UP; d.n0 = 256 * (r >> 2); d.k0 = 512 * (r & 3); return d; }
    r -= U_UP;
    if (r < U_DN) { d.W = FIN(F, I_WDN) + (size_t)l * FF * D; d.ldw = D; d.K = FF; d.Bt = wl + WL_DN; d.n0 = 256 * (r >> 4); d.k0 = 512 * (r & 15); return d; }
    r -= U_DN;
    { d.W = FIN(F, I_PW) + (size_t)l * 4 * 65536 + (size_t)r * 65536; d.ldw = 256; d.K = 256; d.Bt = wl + WL_POOL + (size_t)r * 65536; d.n0 = 0; d.k0 = 0; d.ntk = 4; return d; }
}
constexpr int T1_UP = 60, IN_PRE = 92;
constexpr int R_T1B = U_IN, R_T1E = U_IN + 3 * U_BR + U_OUT + T1_UP, R_T2B = U_IN + 3 * U_BR + U_OUT + U_UP, R_T2E = R_T2B + U_DN, R_POOL = R_T2E;
constexpr int U_FRONT0 = U_IN + U_POOL, U_FRONTL = U_IN - IN_PRE + U_POOL;
struct P0Job { int l, rb, re, cc, Gn; };
template <int KIND> __device__ __forceinline__ int p0_vtile(Frame& F, const P0Job& J, int v, TileDesc& d) {
    int idx = J.cc + J.Gn * (v >> 3), l, r;
    if (KIND == 1) { l = J.l; r = J.rb + idx; if (r >= J.re) return 0; }
    else if (KIND == 2) { if (idx < R_T2B - R_T1E) { l = J.l; r = R_T1E + idx; } else { idx -= R_T2B - R_T1E; l = J.l + 1; r = idx; if (l >= DEPTH || idx >= IN_PRE) return 0; } }
    else { if (idx < U_FRONT0) { l = 0; r = idx < U_IN ? idx : idx - U_IN + R_POOL; }
           else { idx -= U_FRONT0; l = 1 + idx / U_FRONTL; if (l >= DEPTH) return 0; const int j = idx - (l - 1) * U_FRONTL; r = j < U_IN - IN_PRE ? IN_PRE + j : j - (U_IN - IN_PRE) + R_POOL; } }
    d = p0_unit(F, l, r); const int kt = v & 7; if (kt >= d.ntk) return 2; d.k0 += 64 * kt; return 1;
}
__device__ __forceinline__ int win_src(int n) { return n < 6144 ? n : (n < 13312 ? n + 16 : (n < 13328 ? n - 7168 : -1)); }
__device__ __forceinline__ void p0_load(const TileDesc& d, int tid, f32x4 (&v)[8]) {
    const int n4 = tid & 63, kr = tid >> 6; const int nd = d.n0 + 4 * n4; const int src = d.remap ? win_src(nd) : nd;
    const int srcc = src < 0 ? 0 : src; const float mk = src < 0 ? 0.f : 1.f;
#pragma unroll
    for (int i = 0; i < 8; ++i) { const int k = d.k0 + kr + 8 * i; v[i] = __builtin_nontemporal_load((const GAS f32x4*)(d.W + (size_t)k * d.ldw + srcc)) * mk; }
}
template <int KIND> __device__ __forceinline__ void p0_convert(Frame& F, const P0Job& J) {
    const int tid = F.tid;
    f32x4 va[8], vb[8]; TileDesc dA, dB, dcur; int vt = 0, buf = 0, sA, sB = 0;
    while ((sA = p0_vtile<KIND>(F, J, vt, dA)) == 2) ++vt;
    if (sA == 1) { p0_load(dA, tid, va); ++vt; while ((sB = p0_vtile<KIND>(F, J, vt, dB)) == 2) ++vt; if (sB == 1) p0_load(dB, tid, vb); }
#define P0_STEP(VX, DX, SX) do { \
        LAS unsigned char* tile = F.lds + buf * TP_TILE_BYTES; dcur = DX; \
        { const int n4 = tid & 63, kr = tid >> 6; \
          _Pragma("unroll") for (int i = 0; i < 8; ++i) { LAS unsigned* p = (LAS unsigned*)(tile + (kr + 8 * i) * TP_PITCH + 8 * n4); p[0] = pk2(VX[i][0], VX[i][1]); p[1] = pk2(VX[i][2], VX[i][3]); } } \
        ++vt; while ((SX = p0_vtile<KIND>(F, J, vt, DX)) == 2) ++vt; if (SX == 1) p0_load(DX, tid, VX); \
        LDS_WAIT(); __builtin_amdgcn_s_barrier(); asm volatile("" ::: "memory"); \
        { const int koct = tid & 7, nn = tid >> 3; \
          _Pragma("unroll") for (int nr = 0; nr < 4; ++nr) { const int n = nn + 64 * nr, kk = 8 * koct; \
                const LAS unsigned short* s = (const LAS unsigned short*)(tile + kk * TP_PITCH + 2 * n); \
                v4u o; o.x = (unsigned)s[0] | ((unsigned)s[1 * TP_PITCH / 2] << 16); o.y = (unsigned)s[2 * TP_PITCH / 2] | ((unsigned)s[3 * TP_PITCH / 2] << 16); \
                o.z = (unsigned)s[4 * TP_PITCH / 2] | ((unsigned)s[5 * TP_PITCH / 2] << 16); o.w = (unsigned)s[6 * TP_PITCH / 2] | ((unsigned)s[7 * TP_PITCH / 2] << 16); \
                __builtin_nontemporal_store(o, (GAS v4u*)(dcur.Bt + (size_t)(dcur.n0 + n) * dcur.K + dcur.k0 + kk)); } } \
        buf ^= 1; } while (0)
    while (sA == 1) {
        P0_STEP(va, dA, sA);
        if (sB != 1) break;
        P0_STEP(vb, dB, sB);
    }
#undef P0_STEP
    LDS_WAIT(); __builtin_amdgcn_s_barrier();
}
template <int KIND> __device__ __forceinline__ void p0_tail(Frame& F, const int l, const int rb, const int re, const int c0) {
    P0Job J; J.l = l; J.rb = rb; J.re = re; if (c0 < F.G) { J.cc = F.bx - c0; J.Gn = F.G - c0; } else { J.cc = F.bx; J.Gn = F.G; }
    LDS_WAIT(); __builtin_amdgcn_s_barrier();
    if (J.cc >= 0) p0_convert<KIND>(F, J);
}
__device__ __forceinline__ int static_c0(const int nwg, const int G) { const int rounds = (nwg + G - 1) / G; return nwg - (rounds - 1) * G; }

constexpr int NSLAB = 8, NSLAB_OUT = 6;
__device__ __forceinline__ void rms_rows_bf16(Frame& F, float* X, const float* gain, bf16* XN, const bf16* slabs, const int nslab, const float* srcP = nullptr, const float* srcS = nullptr) {
    f32x4 gv[8];
#pragma unroll
    for (int j = 0; j < 8; ++j) gv[j] = ((const GAS f32x4*)gain)[F.lane + 64 * j];
    const int nk = (MP - F.bx + F.G - 1) / F.G, w4 = F.wave - 4;
    const int nprompt = F.wave < 4 ? (nk - 2 * F.wave < 0 ? 0 : (nk - 2 * F.wave > 2 ? 2 : nk - 2 * F.wave)) : (nk > 8 + w4 ? (nk - 8 - w4 + 3) / 4 : 0);
    const int ntot = nprompt + ((F.wave < 4 && (F.wave * F.G + F.bx) < MS) ? 1 : 0);
    for (int it = 0; it < ntot; ++it) {
        const int m = it < nprompt ? F.bx + F.G * (F.wave < 4 ? 2 * F.wave + it : 8 + w4 + 4 * it) : MP + F.wave * F.G + F.bx;
        GAS f32x4* xr = (GAS f32x4*)(X + (size_t)m * D) + F.lane; f32x4 v[8];
        if (srcP) { const GAS f32x4* xs = (const GAS f32x4*)(m < MP ? srcP + (size_t)m * D : srcS + (size_t)(m - MP) * D) + F.lane;
#pragma unroll
            for (int j = 0; j < 8; ++j) v[j] = __builtin_nontemporal_load(xs + 64 * j);
#pragma unroll
            for (int j = 0; j < 8; ++j) xr[64 * j] = v[j]; }
        else {
#pragma unroll
            for (int j = 0; j < 8; ++j) v[j] = xr[64 * j]; }
        if (slabs && m >= MP) {
#pragma unroll
            for (int s = 0; s < NSLAB; ++s) if (s < nslab) { const GAS v2u* sr = (const GAS v2u*)(slabs + ((size_t)s * MS + (m - MP)) * D) + F.lane;
#pragma unroll
                for (int j = 0; j < 8; ++j) { const v2u w = sr[64 * j]; v[j][0] += bflo(w.x); v[j][1] += bfhi(w.x); v[j][2] += bflo(w.y); v[j][3] += bfhi(w.y); } }
#pragma unroll
            for (int j = 0; j < 8; ++j) xr[64 * j] = v[j]; }
        float s = 0.f;
#pragma unroll
        for (int j = 0; j < 8; ++j) s += (v[j][0] * v[j][0] + v[j][1] * v[j][1]) + (v[j][2] * v[j][2] + v[j][3] * v[j][3]);
        const float rstd = __builtin_amdgcn_rsqf(wave_sum(s) * (1.f / D) + EPS);
        GAS v2u* o = (GAS v2u*)(XN + (size_t)m * D) + F.lane;
#pragma unroll
        for (int j = 0; j < 8; ++j) { v2u w; w.x = pk2(v[j][0] * rstd * gv[j][0], v[j][1] * rstd * gv[j][1]); w.y = pk2(v[j][2] * rstd * gv[j][2], v[j][3] * rstd * gv[j][3]); o[64 * j] = w; }
    }
}
__device__ __forceinline__ void rms_rows_f32(Frame& F, const float* X, const float* gain, float* Y, const bf16* slabs) {
    f32x4 gv[8];
#pragma unroll
    for (int j = 0; j < 8; ++j) gv[j] = ((const GAS f32x4*)gain)[F.lane + 64 * j];
    const int nk = (MP - F.bx + F.G - 1) / F.G, w4 = F.wave - 4;
    const int nprompt = F.wave < 4 ? (nk - 2 * F.wave < 0 ? 0 : (nk - 2 * F.wave > 2 ? 2 : nk - 2 * F.wave)) : (nk > 8 + w4 ? (nk - 8 - w4 + 3) / 4 : 0);
    const int ntot = nprompt + ((F.wave < 4 && (F.wave * F.G + F.bx) < MS) ? 1 : 0);
    for (int it = 0; it < ntot; ++it) {
        const int m = it < nprompt ? F.bx + F.G * (F.wave < 4 ? 2 * F.wave + it : 8 + w4 + 4 * it) : MP + F.wave * F.G + F.bx;
        const GAS f32x4* xr = (const GAS f32x4*)(X + (size_t)m * D) + F.lane; f32x4 v[8];
#pragma unroll
        for (int j = 0; j < 8; ++j) v[j] = xr[64 * j];
        if (slabs && m >= MP) {
#pragma unroll
            for (int s = 0; s < NSLAB; ++s) { const GAS v2u* sr = (const GAS v2u*)(slabs + ((size_t)s * MS + (m - MP)) * D) + F.lane;
#pragma unroll
                for (int j = 0; j < 8; ++j) { const v2u w = sr[64 * j]; v[j][0] += bflo(w.x); v[j][1] += bfhi(w.x); v[j][2] += bflo(w.y); v[j][3] += bfhi(w.y); } } }
        float s = 0.f;
#pragma unroll
        for (int j = 0; j < 8; ++j) s += (v[j][0] * v[j][0] + v[j][1] * v[j][1]) + (v[j][2] * v[j][2] + v[j][3] * v[j][3]);
        const float rstd = __builtin_amdgcn_rsqf(wave_sum(s) * (1.f / D) + EPS);
        GAS f32x4* o = (GAS f32x4*)(Y + (size_t)m * D) + F.lane;
#pragma unroll
        for (int j = 0; j < 8; ++j) o[64 * j] = v[j] * rstd * gv[j];
    }
}

__device__ __forceinline__ void st_copy8(float* dst, const bf16* src) { const v4u w = *(const GAS v4u*)src;
    *(GAS f32x4*)dst = (f32x4){bflo(w.x), bfhi(w.x), bflo(w.y), bfhi(w.y)}; *(GAS f32x4*)(dst + 4) = (f32x4){bflo(w.z), bfhi(w.z), bflo(w.w), bfhi(w.w)}; }
__device__ __forceinline__ void state_outputs(Frame& F, int l) {
    const bf16* P = (const bf16*)(F.ws + WS_P);
    const int gid = F.bx * NTHREADS + F.tid, gstride = F.G * NTHREADS;
    for (int i = gid; i < NB * 3 * LW / 8; i += gstride) { const int c = (i % (LW / 8)) * 8, j = (i / (LW / 8)) % 3, b = i / (3 * LW / 8);
        st_copy8(F.out + O_PLC + (size_t)l * NB * 3 * LW + (size_t)i * 8, P + (size_t)(b * T + T - 3 + j) * PW + C_XL + c); }
    for (int i = gid; i < SB * 3 * LW / 8; i += gstride) { const int c = (i % (LW / 8)) * 8, j = (i / (LW / 8)) % 3, b = i / (3 * LW / 8);
        st_copy8(F.out + O_SLC + (size_t)l * SB * 3 * LW + (size_t)i * 8, P + (size_t)(MP + b * ST + ST - 3 + j) * PW + C_XL + c); }
    for (int i = gid; i < NB * 3 * QKVW / 8; i += gstride) { const int c = (i % (QKVW / 8)) * 8, j = (i / (QKVW / 8)) % 3, b = i / (3 * QKVW / 8);
        st_copy8(F.out + O_PDC + (size_t)l * NB * 3 * QKVW + (size_t)i * 8, P + (size_t)(b * T + T - 3 + j) * PW + C_Q + c); }
    for (int i = gid; i < SB * 3 * QKVW / 8; i += gstride) { const int c = (i % (QKVW / 8)) * 8, j = (i / (QKVW / 8)) % 3, b = i / (3 * QKVW / 8);
        st_copy8(F.out + O_SDC + (size_t)l * SB * 3 * QKVW + (size_t)i * 8, P + (size_t)(MP + b * ST + ST - 3 + j) * PW + C_Q + c); }
    for (int i = gid; i < NB * PBUF * PLW / 8; i += gstride) { const int c = (i % (PLW / 8)) * 8, j = (i / (PLW / 8)) % PBUF, b = i / (PBUF * PLW / 8);
        st_copy8(F.out + O_PPL + (size_t)l * NB * PBUF * PLW + (size_t)i * 8, P + (size_t)(b * T + T - PBUF + j) * PW + C_POOL + c); }
    const float* spl = FIN(F, I_SPL) + (size_t)l * SB * PBUF * PLW;
    for (int i = gid; i < SB * PBUF * PLW / 8; i += gstride) { const int c = (i % (PLW / 8)) * 8, j = (i / (PLW / 8)) % PBUF, b = i / (PBUF * PLW / 8);
        float* dst = F.out + O_SPL + (size_t)l * SB * PBUF * PLW + (size_t)i * 8;
        if (j < PBUF - ST) { const GAS f32x4* sp = (const GAS f32x4*)(spl + ((size_t)b * PBUF + j + ST) * PLW + c); *(GAS f32x4*)dst = sp[0]; *(GAS f32x4*)(dst + 4) = sp[1]; }
        else st_copy8(dst, P + (size_t)(MP + b * ST + j - (PBUF - ST)) * PW + C_POOL + c); }
}

struct RowInfo { int smp, b, t, row0; };
__device__ __forceinline__ RowInfo row_info(int row) { RowInfo r; if (row < MP) { r.smp = 0; r.b = row / T; r.t = row - r.b * T; r.row0 = r.b * T; } else { const int q = row - MP; r.smp = 1; r.b = q / ST; r.t = q - r.b * ST; r.row0 = MP + r.b * ST; } return r; }

constexpr int LR_WTA = 0, LR_WTX = 9216, LR_XC = 18432, LR_XCF = 27648, LR_AS = LR_XCF + 64 * 65 * 4, LR_BS = LR_AS + 64 * 65 * 4, LR_SEG = LR_BS + 64 * 65 * 4, LR_END = LR_SEG + 4096;
__device__ __forceinline__ float gelu_tanh(float x) { const float u = 0.7978845608028654f * (x + 0.044715f * x * x * x); return x * __builtin_amdgcn_rcpf(1.0f + __expf(-2.0f * u)); }
__device__ __forceinline__ float sqrt_1mexp2(float la) { const float x = 2.0f * la; const float d = x > -0.0625f ? -x * (1.0f + x * (0.5f + x * (0.16666667f + x * 0.041666668f))) : 1.0f - __expf(x); return __builtin_amdgcn_sqrtf(d); }
__device__ __forceinline__ void lru_phase2(Frame& F, int l) {
    const int n = F.bx & 15, tid = F.tid, lane = F.lane, w = F.wave, g = lane >> 4, r = lane & 15;
    LAS unsigned char* L = lds_opaque(F);
    const bf16* P = (const bf16*)(F.ws + WS_P);
    { const float* wa = FIN(F, I_LAW) + ((size_t)l * 16 + n) * 4096; const float* wx = FIN(F, I_LXW) + ((size_t)l * 16 + n) * 4096;
#pragma unroll
      for (int i = 0; i < 8; ++i) { const int e = tid + 512 * i, c = e >> 6, d = e & 63;
          *(LAS bf16*)(L + LR_WTA + d * 144 + c * 2) = (bf16)(pk2(wa[e], 0.f) & 0xffffu); *(LAS bf16*)(L + LR_WTX + d * 144 + c * 2) = (bf16)(pk2(wx[e], 0.f) & 0xffffu); } }
    const int mt = w & 3, np = w >> 2;
    float cba[2], cbx[2], csp[2];
#pragma unroll
    for (int q = 0; q < 2; ++q) { const int ch = n * 64 + 16 * (2 * np + q) + r; cba[q] = FIN(F, I_LAB)[(size_t)l * LW + ch]; cbx[q] = FIN(F, I_LXB)[(size_t)l * LW + ch]; csp[q] = softplusf(-FIN(F, I_LLAM)[(size_t)l * LW + ch]); }
    const int d = tid & 63, rg = tid >> 6, ch = n * 64 + d;
    const float* cw = FIN(F, I_LCW) + (size_t)l * 4 * LW; const float cb = FIN(F, I_LCB)[(size_t)l * LW + ch];
    const float w0 = cw[ch], w1 = cw[LW + ch], w2 = cw[2 * LW + ch], w3 = cw[3 * LW + ch];
    const float* hist = FIN(F, I_SLC) + (size_t)l * SB * 3 * LW;
    float* HLp = (float*)(F.ws + WS_ALRU); float* CAp = (float*)(F.ws + WS_BLRU); bf16* OL = (bf16*)(F.ws + WS_OL);
    __syncthreads();
#define LRU_FETCH(rt_, XM_) do { const int row_ = (rt_) * 64 + rg * 8; const RowInfo ri_ = row_info(row_); \
        _Pragma("unroll") for (int m = 0; m < 11; ++m) { const int tt = ri_.t + m - 3, tc = tt < 0 ? 0 : tt; \
            const float pv_ = bf2f(P[(size_t)(ri_.row0 + tc) * PW + C_XL + ch]);                                     \
            const float hv_ = hist[((size_t)(ri_.smp ? ri_.b : 0) * 3 + (tt < 0 ? tt + 3 : 0)) * LW + ch]; \
            const float pm_ = tt >= 0 ? 1.f : 0.f, hm_ = (tt < 0 && ri_.smp) ? 1.f : 0.f; \
            XM_[m] = pm_ * pv_ + hm_ * hv_; } } while (0)
    float xm[11], xmn[11];
    if ((F.bx >> 4) < M / 64) LRU_FETCH(F.bx >> 4, xm);
    for (int rt = F.bx >> 4; rt < M / 64; rt += F.G >> 4) {
        const bool smp = rt >= MP / 64;
        {
#pragma unroll
          for (int i = 0; i < 8; ++i) { const float xc = w0 * xm[i] + w1 * xm[i + 1] + w2 * xm[i + 2] + w3 * xm[i + 3] + cb;
              *(LAS bf16*)(L + LR_XC + (rg * 8 + i) * 144 + d * 2) = (bf16)(pk2(xc, 0.f) & 0xffffu); ((LAS float*)(L + LR_XCF))[(rg * 8 + i) * 65 + d] = xc; } }
        if (rt + (F.G >> 4) < M / 64) LRU_FETCH(rt + (F.G >> 4), xmn);
        __syncthreads();
        { f32x4 aa[2], ax[2];
#pragma unroll
          for (int q = 0; q < 2; ++q) { aa[q] = (f32x4){0.f, 0.f, 0.f, 0.f}; ax[q] = (f32x4){0.f, 0.f, 0.f, 0.f}; }
#pragma unroll
          for (int s = 0; s < 2; ++s) { const bf16x8 af = *(const LAS bf16x8*)(L + LR_XC + (16 * mt + r) * 144 + (32 * s + 8 * g) * 2);
#pragma unroll
              for (int q = 0; q < 2; ++q) { const int dd = 16 * (2 * np + q) + r;
                  aa[q] = __builtin_amdgcn_mfma_f32_16x16x32_bf16(af, *(const LAS bf16x8*)(L + LR_WTA + dd * 144 + (32 * s + 8 * g) * 2), aa[q], 0, 0, 0);
                  ax[q] = __builtin_amdgcn_mfma_f32_16x16x32_bf16(af, *(const LAS bf16x8*)(L + LR_WTX + dd * 144 + (32 * s + 8 * g) * 2), ax[q], 0, 0, 0); } }
#pragma unroll
          for (int q = 0; q < 2; ++q)
#pragma unroll
              for (int e = 0; e < 4; ++e) { const int rr = 16 * mt + 4 * g + e, dd = 16 * (2 * np + q) + r;
                  const float xcv = ((const LAS float*)(L + LR_XCF))[rr * 65 + dd];
                  const float rv = sigm(aa[q][e] + cba[q]), iv = sigm(ax[q][e] + cbx[q]), la = -8.0f * rv * csp[q];
                  ((LAS float*)(L + LR_AS))[rr * 65 + dd] = __expf(la); ((LAS float*)(L + LR_BS))[rr * 65 + dd] = sqrt_1mexp2(la) * (iv * xcv); } }
        __syncthreads();
        { float a[8], bt[8];
#pragma unroll
          for (int i = 0; i < 8; ++i) { a[i] = ((const LAS float*)(L + LR_AS))[(rg * 8 + i) * 65 + d]; bt[i] = ((const LAS float*)(L + LR_BS))[(rg * 8 + i) * 65 + d]; }
          if (smp) {
              const int b = (rt * 64 + rg * 8 - MP) >> 3, row0 = rt * 64 + rg * 8; float h = FIN(F, I_SLH)[((size_t)l * SB + b) * LW + ch];
              float gl[8];
#pragma unroll
              for (int i = 0; i < 8; ++i) gl[i] = bf2f(P[(size_t)(row0 + i) * PW + C_GL + ch]);
#pragma unroll
              for (int i = 0; i < 8; ++i) { h = a[i] * h + bt[i]; OL[(size_t)(row0 + i) * LW + ch] = (bf16)(pk2(h * gelu_tanh(gl[i]), 0.f) & 0xffffu); }
              F.out[O_SLH + ((size_t)l * SB + b) * LW + ch] = h;
          } else {
              float ap = 1.f, h = 0.f;
#pragma unroll
              for (int i = 0; i < 8; ++i) { h = a[i] * h + bt[i]; ap *= a[i]; }
              LAS float* seg = (LAS float*)(L + LR_SEG);
              seg[rg * 64 + d] = ap; seg[512 + rg * 64 + d] = h;
              __syncthreads();
              float cA = 1.f, cH = 0.f;
              for (int s = 0; s < rg; ++s) { const float sa = seg[s * 64 + d]; cH = sa * cH + seg[512 + s * 64 + d]; cA *= sa; }
              const int row0 = rt * 64 + rg * 8;
#pragma unroll
              for (int i = 0; i < 8; ++i) { cH = a[i] * cH + bt[i]; cA *= a[i]; HLp[(size_t)(row0 + i) * LW + ch] = cH; CAp[(size_t)(row0 + i) * LW + ch] = cA; }
          } }
#pragma unroll
        for (int m = 0; m < 11; ++m) xm[m] = xmn[m];
        __syncthreads();
    }
#undef LRU_FETCH
}
__device__ __forceinline__ void dn_pre_item(Frame& F, int l, int item) {
    const int row = item >> 3, h = item & 7, lane = F.lane; const RowInfo ri = row_info(row);
    const bf16* P = (const bf16*)(F.ws + WS_P);
    const float* cw = FIN(F, I_DCW) + (size_t)l * 4 * QKVW; const float* hist = FIN(F, I_SDC) + (size_t)l * SB * 3 * QKVW;
    float val[3][2];
#pragma unroll
    for (int s = 0; s < 3; ++s)
#pragma unroll
        for (int e = 0; e < 2; ++e) { const int c = s * 1024 + h * 128 + 2 * lane + e; float acc = 0.f;
#pragma unroll
            for (int j = 0; j < 4; ++j) { const int tt = ri.t + j - 3;
                const float x = tt >= 0 ? bf2f(P[(size_t)(ri.row0 + tt) * PW + C_Q + c]) : (ri.smp ? hist[((size_t)ri.b * 3 + (tt + 3)) * QKVW + c] : 0.f);
                acc += cw[j * QKVW + c] * x; }
            val[s][e] = siluf(acc); }
    const float qs = wave_sum(val[0][0] * val[0][0] + val[0][1] * val[0][1]), ks = wave_sum(val[1][0] * val[1][0] + val[1][1] * val[1][1]);
    const float qn = (1.0f / sqrtf(qs + EPS)) * 0.08838834764831845f, kn = 1.0f / sqrtf(ks + EPS);
    float* QN = (float*)(F.ws + WS_QN); float* KN = (float*)(F.ws + WS_KN); float* VN = (float*)(F.ws + WS_VN);
    const size_t o = (size_t)row * LW + h * 128 + 2 * lane;
    *(f32x2*)(QN + o) = (f32x2){val[0][0] * qn, val[0][1] * qn}; *(f32x2*)(KN + o) = (f32x2){val[1][0] * kn, val[1][1] * kn}; *(f32x2*)(VN + o) = (f32x2){val[2][0], val[2][1]};
    if (lane == 0) { const float* BA = (const float*)(F.ws + WS_BA) + (size_t)row * 16;
        float* BG = (float*)(F.ws + WS_BG) + (size_t)row * 16;
        BG[h] = sigm(BA[h]);
        BG[8 + h] = -__expf(FIN(F, I_DALOG)[l * NH + h]) * softplusf(BA[8 + h] + FIN(F, I_DDT)[l * NH + h]); }
}
__device__ __forceinline__ void pool_d_rows(Frame& F, int l) {
    const bf16* P = (const bf16*)(F.ws + WS_P); bf16* PD = (bf16*)(F.ws + WS_PD);
    const float* hist = FIN(F, I_SPL) + (size_t)l * SB * PBUF * PLW;
    const int total = (M / 8) * (PLW / 2), stride = F.G * NTHREADS;
    for (int it = F.bx * NTHREADS + F.tid; it < total; it += stride) {
        const int tile = it / (PLW / 2), c = 2 * (it % (PLW / 2)), g = c >> 8, w = 2 << g, row = tile * 8; const RowInfo ri = row_info(row);
        float x0[23], x1[23];
#pragma unroll
        for (int m = 0; m < 23; ++m) { const int tt = ri.t + m - 15, tc = tt < 0 ? 0 : tt;
            const unsigned pw = *(const GAS unsigned*)(P + (size_t)(ri.row0 + tc) * PW + C_POOL + c);
            const float pm = tt >= 0 ? 1.f : 0.f; x0[m] = pm * bflo(pw); x1[m] = pm * bfhi(pw); }
        if (ri.smp) {
#pragma unroll
            for (int m = 0; m < 15; ++m) { const f32x2 hv = *(const GAS f32x2*)(hist + ((size_t)ri.b * PBUF + m) * PLW + c); x0[m] = hv[0]; x1[m] = hv[1]; } }
        float c0[24], c1[24]; c0[0] = 0.f; c1[0] = 0.f;
#pragma unroll
        for (int m = 0; m < 23; ++m) { c0[m + 1] = c0[m] + x0[m]; c1[m + 1] = c1[m] + x1[m]; }
#pragma unroll
        for (int i = 0; i < 8; ++i) { const int pos = ri.t + i + 1 + (ri.smp ? 16384 : 0); const float inv = 1.0f / (float)(pos < w ? pos : w);
            float s0, s1;
            if (g == 0) { s0 = c0[16 + i] - c0[14 + i]; s1 = c1[16 + i] - c1[14 + i]; } else if (g == 1) { s0 = c0[16 + i] - c0[12 + i]; s1 = c1[16 + i] - c1[12 + i]; }
            else if (g == 2) { s0 = c0[16 + i] - c0[8 + i]; s1 = c1[16 + i] - c1[8 + i]; } else { s0 = c0[16 + i] - c0[i]; s1 = c1[16 + i] - c1[i]; }
            *(GAS unsigned*)(PD + ((size_t)g * M + row + i) * 256 + (c & 255)) = pk2(s0 * inv - x0[15 + i], s1 * inv - x1[15 + i]); }
    }
}

constexpr int LF_OFF = RING_OFF + RING_BYTES + 4096;
__device__ __forceinline__ void lru_fix_unit(Frame& F, int l, int unit, int par) {
    const int b = unit >> 8, c = (unit >> 3) & 31, cb = (unit & 7) * 128, q4 = (F.tid & 31) * 4, rg = F.tid >> 5;
    const float* HL = (const float*)(F.ws + WS_ALRU); const float* CA = (const float*)(F.ws + WS_BLRU); const bf16* P = (const bf16*)(F.ws + WS_P); bf16* OL = (bf16*)(F.ws + WS_OL);
    LAS float* Hs = (LAS float*)(F.lds + LF_OFF) + par * 128;
    const int row0 = b * T + c * 64 + rg * 4;
    f32x4 xa[4], xh[4]; v2u gl[4];
#pragma unroll
    for (int i = 0; i < 4; ++i) { const size_t rr = (size_t)(row0 + i); xa[i] = *(const GAS f32x4*)(CA + rr * LW + cb + q4); xh[i] = *(const GAS f32x4*)(HL + rr * LW + cb + q4); gl[i] = *(const GAS v2u*)(P + rr * PW + C_GL + cb + q4); }
    if (F.tid < 128) { const int ch = cb + F.tid; float ca[31], hl[31];
#pragma unroll
        for (int cc = 0; cc < 31; ++cc) { const size_t last = (size_t)(b * T + cc * 64 + 63); const float av = CA[last * LW + ch], hv = HL[last * LW + ch]; const float mk = cc < c ? 1.f : 0.f; ca[cc] = 1.f + mk * (av - 1.f); hl[cc] = mk * hv; }
        float h = 0.f;
#pragma unroll
        for (int cc = 0; cc < 31; ++cc) h = ca[cc] * h + hl[cc];
        Hs[F.tid] = h; }
    LDS_WAIT(); __builtin_amdgcn_s_barrier(); asm volatile("" ::: "memory");
    const f32x4 h4 = *(const LAS f32x4*)(Hs + q4);
#pragma unroll
    for (int i = 0; i < 4; ++i) { const f32x4 hh = xh[i] + xa[i] * h4; v2u o;
        o.x = pk2(hh[0] * gelu_tanh(bflo(gl[i].x)), hh[1] * gelu_tanh(bfhi(gl[i].x))); o.y = pk2(hh[2] * gelu_tanh(bflo(gl[i].y)), hh[3] * gelu_tanh(bfhi(gl[i].y)));
        *(GAS v2u*)(OL + (size_t)(row0 + i) * LW + cb + q4) = o;
        if (i == 3 && c == 31 && rg == 15) *(GAS f32x4*)(F.out + O_PLH + ((size_t)l * NB + b) * LW + cb + q4) = hh; }
}
constexpr int SD_Q = 0, SD_K = 4096, SD_V = 8192, SD_BG = 12288, SD_AKK = 12416, SD_AQK = 12672, SD_RED = 12928, SD_O = SD_RED + 2 * 8 * 4 * 128 * 4, SD_END = SD_O + 8 * 128 * 4;
struct SmpIn { float S[32]; unsigned zw; };
__device__ __forceinline__ void dn_sample_load(Frame& F, int l, int unit, SmpIn& in) {
    int lane = F.lane; asm volatile("" : "+v"(lane));
    const int b = unit >> 3, h = unit & 7, w = F.wave, row0 = MP + b * ST, g = lane >> 4, r = lane & 15;
    const bf16* P = (const bf16*)(F.ws + WS_P);
    const float* s0 = FIN(F, I_SDS) + (((size_t)l * SB + b) * NH + h) * HD * HD + 16 * w + r;
#pragma unroll
    for (int s = 0; s < 4; ++s)
#pragma unroll
        for (int j = 0; j < 8; ++j) in.S[8 * s + j] = s0[(size_t)(32 * s + 8 * g + j) * HD];
    in.zw = *(const GAS unsigned*)(P + (size_t)(row0 + w) * PW + C_Z + h * 128 + 2 * lane);
}
__device__ __forceinline__ void dn_sample_unit(Frame& F, int l, int unit, SmpIn& in) {
    int lane = F.lane; asm volatile("" : "+v"(lane));
    const int b = unit >> 3, h = unit & 7, w = F.wave, tid = w * 64 + lane, row0 = MP + b * ST;
    LAS unsigned char* L = lds_opaque(F);
    LAS float* Qs = (LAS float*)(L + SD_Q); LAS float* Ks = (LAS float*)(L + SD_K); LAS float* Vs = (LAS float*)(L + SD_V); LAS float* bg = (LAS float*)(L + SD_BG);
    LAS float* Akk = (LAS float*)(L + SD_AKK); LAS float* Aqk = (LAS float*)(L + SD_AQK); LAS float* red = (LAS float*)(L + SD_RED); LAS float* os = (LAS float*)(L + SD_O);
    float (&S)[32] = in.S;
    const bf16* P = (const bf16*)(F.ws + WS_P);
    { float val[3][2]; const float* cw = FIN(F, I_DCW) + (size_t)l * 4 * QKVW; const float* hist = FIN(F, I_SDC) + ((size_t)l * SB + b) * 3 * QKVW; const float* BA = (const float*)(F.ws + WS_BA) + (size_t)(row0 + w) * 16; const float bab = BA[h], baa = BA[8 + h]; const float alog = FIN(F, I_DALOG)[l * NH + h], dtb = FIN(F, I_DDT)[l * NH + h];
#pragma unroll
      for (int s = 0; s < 3; ++s) { float a0 = 0.f, a1 = 0.f; const int c = s * 1024 + h * 128 + 2 * lane;
#pragma unroll
          for (int j = 0; j < 4; ++j) { const int tt = w + j - 3; const unsigned pw = *(const GAS unsigned*)(P + (size_t)(row0 + (tt < 0 ? 0 : tt)) * PW + C_Q + c); const f32x2 hv = *(const GAS f32x2*)(hist + (size_t)(tt < 0 ? tt + 3 : 0) * QKVW + c), wv = *(const GAS f32x2*)(cw + (size_t)j * QKVW + c);
              const float pm = tt >= 0 ? 1.f : 0.f, hm = 1.f - pm; const float x0 = pm * bflo(pw) + hm * hv[0], x1 = pm * bfhi(pw) + hm * hv[1];
              a0 += wv[0] * x0; a1 += wv[1] * x1; }
          val[s][0] = siluf(a0); val[s][1] = siluf(a1); }
      const float qs = wave_sum(val[0][0] * val[0][0] + val[0][1] * val[0][1]), ks = wave_sum(val[1][0] * val[1][0] + val[1][1] * val[1][1]);
      const float qn = __builtin_amdgcn_rsqf(qs + EPS) * 0.08838834764831845f, kn = __builtin_amdgcn_rsqf(ks + EPS);
      *(LAS f32x2*)(Qs + w * 128 + 2 * lane) = (f32x2){val[0][0] * qn, val[0][1] * qn}; *(LAS f32x2*)(Ks + w * 128 + 2 * lane) = (f32x2){val[1][0] * kn, val[1][1] * kn};
      *(LAS f32x2*)(Vs + w * 128 + 2 * lane) = (f32x2){val[2][0], val[2][1]};
      if (lane == 0) { bg[w] = sigm(bab); bg[8 + w] = -__expf(alog) * softplusf(baa + dtb); } }
    __syncthreads();
    float gam[8];
    { float a = 0.f;
#pragma unroll
      for (int t = 0; t < 8; ++t) { a += bg[8 + t]; gam[t] = a; } }
    { const int o = tid >> 2, qd = tid & 3, which = o >> 6, t = (o >> 3) & 7, j = o & 7; const LAS float* x = (which ? Qs : Ks) + t * 128 + qd * 32; const LAS float* y = Ks + j * 128 + qd * 32; float acc = 0.f;
#pragma unroll
      for (int i = 0; i < 32; i += 4) { const f32x4 xa = *(const LAS f32x4*)(x + i), ya = *(const LAS f32x4*)(y + i); acc += (xa[0] * ya[0] + xa[1] * ya[1]) + (xa[2] * ya[2] + xa[3] * ya[3]); }
      acc += __shfl_xor(acc, 1); acc += __shfl_xor(acc, 2);
      if (qd == 0) { const float dec = __expf(gam[t] - gam[j]);
          if (which == 0) Akk[t * 8 + j] = (j < t) ? bg[t] * dec * acc : 0.f; else Aqk[t * 8 + j] = (j <= t) ? dec * acc : 0.f; } }
    const int g = lane >> 4, r = lane & 15;
    f32x4 ak = (f32x4){0.f, 0.f, 0.f, 0.f}, aq = ak;
    { const unsigned rmask = r < 8 ? 0xffffffffu : 0u;
#pragma unroll
      for (int st = 0; st < 4; ++st) {
          const f32x4 k0 = *(const LAS f32x4*)(Ks + (r & 7) * 128 + 32 * st + 8 * g), k1 = *(const LAS f32x4*)(Ks + (r & 7) * 128 + 32 * st + 8 * g + 4);
          const f32x4 q0 = *(const LAS f32x4*)(Qs + (r & 7) * 128 + 32 * st + 8 * g), q1 = *(const LAS f32x4*)(Qs + (r & 7) * 128 + 32 * st + 8 * g + 4);
          v4u ka, qa, sb; ka.x = pk2(k0[0], k0[1]) & rmask; ka.y = pk2(k0[2], k0[3]) & rmask; ka.z = pk2(k1[0], k1[1]) & rmask; ka.w = pk2(k1[2], k1[3]) & rmask;
          qa.x = pk2(q0[0], q0[1]) & rmask; qa.y = pk2(q0[2], q0[3]) & rmask; qa.z = pk2(q1[0], q1[1]) & rmask; qa.w = pk2(q1[2], q1[3]) & rmask;
          sb.x = pk2(S[8 * st], S[8 * st + 1]); sb.y = pk2(S[8 * st + 2], S[8 * st + 3]); sb.z = pk2(S[8 * st + 4], S[8 * st + 5]); sb.w = pk2(S[8 * st + 6], S[8 * st + 7]);
          ak = __builtin_amdgcn_mfma_f32_16x16x32_bf16(__builtin_bit_cast(bf16x8, ka), __builtin_bit_cast(bf16x8, sb), ak, 0, 0, 0);
          aq = __builtin_amdgcn_mfma_f32_16x16x32_bf16(__builtin_bit_cast(bf16x8, qa), __builtin_bit_cast(bf16x8, sb), aq, 0, 0, 0); } }
    f32x4 Sc[8];
    { const float* s0c = FIN(F, I_SDS) + (((size_t)l * SB + b) * NH + h) * HD * HD + 16 * w + r;
#pragma unroll
      for (int kb = 0; kb < 8; ++kb)
#pragma unroll
          for (int e = 0; e < 4; ++e) Sc[kb][e] = s0c[(size_t)(16 * kb + 4 * g + e) * HD]; }
    __syncthreads();
    float wt[8];
    { float kS[8], qS[8];
#pragma unroll
      for (int e = 0; e < 4; ++e) { const float ko = __shfl_xor(ak[e], 16), qo = __shfl_xor(aq[e], 16);
          kS[e] = (g & 1) ? ko : ak[e]; kS[4 + e] = (g & 1) ? ak[e] : ko; qS[e] = (g & 1) ? qo : aq[e]; qS[4 + e] = (g & 1) ? aq[e] : qo; }
      const int v = 16 * w + r; const float g7 = gam[7];
#pragma unroll
      for (int t = 0; t < 8; ++t) { const float eg = __expf(gam[t]);
          float acc = bg[t] * (Vs[t * 128 + v] - eg * kS[t]), oo = eg * qS[t];
#pragma unroll
          for (int j = 0; j < 8; ++j) if (j < t) { acc -= Akk[t * 8 + j] * wt[j]; oo += Aqk[t * 8 + j] * wt[j]; }
          wt[t] = acc; oo += Aqk[t * 8 + t] * acc;
          if (g == 0) os[t * 128 + v] = oo; }
      const float e7 = __expf(g7); const unsigned gmask = g == 0 ? 0xffffffffu : 0u;
#pragma unroll
      for (int t = 0; t < 8; ++t) wt[t] *= __expf(g7 - gam[t]);
      v4u wb; wb.x = pk2(wt[0], wt[1]) & gmask; wb.y = pk2(wt[2], wt[3]) & gmask; wb.z = pk2(wt[4], wt[5]) & gmask; wb.w = pk2(wt[6], wt[7]) & gmask;
      float* so = F.out + O_SDS + (((size_t)l * SB + b) * NH + h) * HD * HD + 16 * w + r;
#pragma unroll
      for (int kb = 0; kb < 8; ++kb) { float kc[8];
#pragma unroll
          for (int j = 0; j < 8; ++j) kc[j] = Ks[j * 128 + 16 * kb + r];
          v4u ka; ka.x = pk2(kc[0], kc[1]) & gmask; ka.y = pk2(kc[2], kc[3]) & gmask; ka.z = pk2(kc[4], kc[5]) & gmask; ka.w = pk2(kc[6], kc[7]) & gmask;
          f32x4 acc = Sc[kb] * e7;
          acc = __builtin_amdgcn_mfma_f32_16x16x32_bf16(__builtin_bit_cast(bf16x8, ka), __builtin_bit_cast(bf16x8, wb), acc, 0, 0, 0);
#pragma unroll
          for (int e = 0; e < 4; ++e) so[(size_t)(16 * kb + 4 * g + e) * HD] = acc[e];
          asm volatile("" ::: "memory"); } }
    __syncthreads();
    { const f32x2 ov = *(const LAS f32x2*)(os + w * 128 + 2 * lane); const float ss = wave_sum(ov[0] * ov[0] + ov[1] * ov[1]); const float rstd = __builtin_amdgcn_rsqf(ss * (1.0f / 128.0f) + EPS);
      const f32x2 nw = *(const GAS f32x2*)(FIN(F, I_DNW) + l * HD + 2 * lane); const unsigned zw = in.zw;
      *(GAS unsigned*)((bf16*)(F.ws + WS_OD) + (size_t)(row0 + w) * LW + h * 128 + 2 * lane) = pk2(ov[0] * rstd * nw[0] * siluf(bflo(zw)), ov[1] * rstd * nw[1] * siluf(bfhi(zw))); }
    __syncthreads();
}
constexpr int DB_NEGWK = 0, DB_QG = 8192, DB_KDT = 16384, DB_QKD = 24576, DB_UT = 26624, DB_SC = 34816, DB_IMG = 35840;
static_assert(DNP_BLOB >= 2 * DB_IMG, "blob size");
__device__ __forceinline__ int frag_off(int row, int k, int ns) { return ((row >> 4) * ns + (k >> 5)) * 1024 + ((((k >> 2) & 3) * 16 + (row & 15)) * 16) + ((((k >> 4) & 1) * 4 + (k & 3)) * 2); }
constexpr int KP = 132;
constexpr int PL_Q = 0, PL_K = 64 * KP * 4, PL_V = 2 * 64 * KP * 4, PL_A = 3 * 64 * KP * 4, PL_QK = PL_A + 8192, PL_GAM = PL_QK + 8192, PL_BET = PL_GAM + 256, PL_BEK = PL_BET + 256, PL_END = PL_BEK + 256;
constexpr int KBP = 272;
constexpr int PL_KB = PL_END, PL_QB = PL_KB + 64 * KBP, PL_END2 = PL_QB + 64 * KBP;
static_assert(PL_KB % 16 == 0 && PL_END2 <= MISC_OFF, "prep LDS map");
static_assert(PL_END <= MISC_OFF - 1024, "prep LDS");

template <int I> __device__ __forceinline__ void dn_solve_row(float (&x)[32], const LAS float* As, const LAS float* coef, const LAS float* src) {
    float acc = coef[I] * src[I * KP];
#pragma unroll
    for (int j4 = 0; j4 < (I + 3) / 4; ++j4) { const f32x4 a4 = *(const LAS f32x4*)(As + I * 32 + 4 * j4);
        acc -= a4[0] * x[4 * j4]; if (4 * j4 + 1 < I) acc -= a4[1] * x[4 * j4 + 1]; if (4 * j4 + 2 < I) acc -= a4[2] * x[4 * j4 + 2]; if (4 * j4 + 3 < I) acc -= a4[3] * x[4 * j4 + 3]; }
    x[I] = acc; asm volatile("" ::: "memory");
}
template <int I> struct DnSolve { static __device__ __forceinline__ void run(float (&x)[32], const LAS float* As, const LAS float* coef, const LAS float* src) { DnSolve<I - 1>::run(x, As, coef, src); dn_solve_row<I>(x, As, coef, src); } };
template <> struct DnSolve<-1> { static __device__ __forceinline__ void run(float (&)[32], const LAS float*, const LAS float*, const LAS float*) {} };

__device__ __forceinline__ void dn_prep_unit(Frame& F, int l, int unit) {
    int lane = F.lane; asm volatile("" : "+v"(lane));
    const int c = unit & 31, h = (unit >> 5) & 7, b = unit >> 8, tid = F.wave * 64 + lane;
    const int row0 = b * T + c * 64;
    const bf16* P = (const bf16*)(F.ws + WS_P);
    LAS unsigned char* L = lds_opaque(F);
    LAS float* Qs = (LAS float*)(L + PL_Q); LAS float* Ks = (LAS float*)(L + PL_K); LAS float* Vs = (LAS float*)(L + PL_V);
    LAS float* As = (LAS float*)(L + PL_A); LAS float* QKs = (LAS float*)(L + PL_QK); LAS float* gam = (LAS float*)(L + PL_GAM); LAS float* bet = (LAS float*)(L + PL_BET); LAS float* bek = (LAS float*)(L + PL_BEK);
    unsigned char* blob = F.ws + WS_DNP + (size_t)((b * NH + h) * 64 + 2 * c) * DB_IMG;
    if (tid < 384) { const int s = tid >> 7, rg = (tid >> 3) & 15, seg = tid & 7, col = s * 1024 + h * 128 + seg * 16; const float* cw = FIN(F, I_DCW) + (size_t)l * 4 * QKVW;
      v4u xin[7][2]; f32x4 w[4][4];
#pragma unroll
      for (int jr = 0; jr < 7; ++jr) { const int tt = c * 64 + 4 * rg + jr - 3; const unsigned mb = tt >= 0 ? 0xffffffffu : 0u;
          const GAS v4u* src = (const GAS v4u*)(P + (size_t)(b * T + (tt < 0 ? 0 : tt)) * PW + C_Q + col); const v4u t0 = src[0], t1 = src[1];
          xin[jr][0] = (v4u){t0.x & mb, t0.y & mb, t0.z & mb, t0.w & mb}; xin[jr][1] = (v4u){t1.x & mb, t1.y & mb, t1.z & mb, t1.w & mb}; }
#pragma unroll
      for (int j = 0; j < 4; ++j) { const GAS f32x4* wp = (const GAS f32x4*)(cw + (size_t)j * QKVW + col);
#pragma unroll
          for (int q = 0; q < 4; ++q) w[j][q] = wp[q]; }
#pragma unroll
      for (int rr = 0; rr < 4; ++rr) { float acc[16];
#pragma unroll
          for (int i = 0; i < 16; ++i) acc[i] = 0.f;
#pragma unroll
          for (int j = 0; j < 4; ++j) { const v4u x0 = xin[rr + j][0], x1 = xin[rr + j][1];
              acc[0] += w[j][0][0] * bflo(x0.x); acc[1] += w[j][0][1] * bfhi(x0.x); acc[2] += w[j][0][2] * bflo(x0.y); acc[3] += w[j][0][3] * bfhi(x0.y);
              acc[4] += w[j][1][0] * bflo(x0.z); acc[5] += w[j][1][1] * bfhi(x0.z); acc[6] += w[j][1][2] * bflo(x0.w); acc[7] += w[j][1][3] * bfhi(x0.w);
              acc[8] += w[j][2][0] * bflo(x1.x); acc[9] += w[j][2][1] * bfhi(x1.x); acc[10] += w[j][2][2] * bflo(x1.y); acc[11] += w[j][2][3] * bfhi(x1.y);
              acc[12] += w[j][3][0] * bflo(x1.z); acc[13] += w[j][3][1] * bfhi(x1.z); acc[14] += w[j][3][2] * bflo(x1.w); acc[15] += w[j][3][3] * bfhi(x1.w); }
          float ss = 0.f;
#pragma unroll
          for (int i = 0; i < 16; ++i) { acc[i] = siluf(acc[i]); ss += acc[i] * acc[i]; }
          float sc = 1.f;
          if (s < 2) { ss += __shfl_xor(ss, 1); ss += __shfl_xor(ss, 2); ss += __shfl_xor(ss, 4); sc = __builtin_amdgcn_rsqf(ss + EPS) * (s == 0 ? 0.08838834764831845f : 1.0f); }
          const int tr = 4 * rg + rr;
          LAS float* dst = (s == 0 ? Qs : (s == 1 ? Ks : Vs)) + tr * KP + seg * 16;
#pragma unroll
          for (int i = 0; i < 16; i += 4) *(LAS f32x4*)(dst + i) = (f32x4){acc[i] * sc, acc[i + 1] * sc, acc[i + 2] * sc, acc[i + 3] * sc};
          if (s < 2) { LAS v4u* db = (LAS v4u*)(L + (s == 0 ? PL_QB : PL_KB) + tr * KBP + seg * 32);
#pragma unroll
              for (int i = 0; i < 16; i += 8) { v4u o; o.x = pk2(acc[i] * sc, acc[i + 1] * sc); o.y = pk2(acc[i + 2] * sc, acc[i + 3] * sc); o.z = pk2(acc[i + 4] * sc, acc[i + 5] * sc); o.w = pk2(acc[i + 6] * sc, acc[i + 7] * sc); db[i >> 3] = o; } } } }
    if (tid < 64) { const float* BA = (const float*)(F.ws + WS_BA) + (size_t)(row0 + tid) * 16;
        const float be = sigm(BA[h]); float g = -__expf(FIN(F, I_DALOG)[l * NH + h]) * softplusf(BA[8 + h] + FIN(F, I_DDT)[l * NH + h]);
#pragma unroll
        for (int o = 1; o < 32; o <<= 1) { const float t = __shfl_up(g, o); if ((lane & 31) >= o) g += t; }
        gam[tid] = g; bet[tid] = be; bek[tid] = be * __expf(g); }
    __syncthreads();
    { const int a = F.wave >> 2, mat = (F.wave >> 1) & 1, mi = F.wave & 1, r = lane & 15, g = lane >> 4;
      const LAS unsigned char* Ab = L + (mat ? PL_QB : PL_KB) + (32 * a + 16 * mi + r) * KBP + 16 * g;
      const LAS unsigned char* Bb = L + PL_KB + (32 * a + r) * KBP + 16 * g;
      f32x4 kq[2]; kq[0] = (f32x4){0.f, 0.f, 0.f, 0.f}; kq[1] = kq[0];
#pragma unroll
      for (int ks = 0; ks < 4; ++ks) { const bf16x8 af = *(const LAS bf16x8*)(Ab + 64 * ks);
#pragma unroll
          for (int nj = 0; nj < 2; ++nj) { const bf16x8 bf = *(const LAS bf16x8*)(Bb + 16 * nj * KBP + 64 * ks); kq[nj] = __builtin_amdgcn_mfma_f32_16x16x32_bf16(af, bf, kq[nj], 0, 0, 0); } }
      LAS float* dm = (mat ? QKs : As) + a * 1024;
#pragma unroll
      for (int nj = 0; nj < 2; ++nj) { const int jq = 16 * nj + r; const float gj = gam[32 * a + jq];
#pragma unroll
          for (int q = 0; q < 4; ++q) { const int il = 16 * mi + 4 * g + q; const float dec = __expf(gam[32 * a + il] - gj), bi = bet[32 * a + il];
              dm[il * 32 + jq] = mat ? ((jq <= il) ? dec * kq[nj][q] : 0.f) : ((jq < il) ? bi * dec * kq[nj][q] : 0.f); } } }
    __syncthreads();
    { const int a = tid >> 8, cc = tid & 127; const bool isK = (tid >> 7) & 1; float x[32];
      DnSolve<31>::run(x, As + a * 1024, (isK ? bek : bet) + 32 * a, (isK ? Ks : Vs) + 32 * a * KP + cc);
      unsigned char* img = blob + a * DB_IMG;
      if (!isK) { unsigned char* dst = img + DB_UT + (cc >> 4) * 1024 + (cc & 15) * 16;
#pragma unroll
          for (int i = 0; i < 8; ++i) { v2u o; o.x = pk2(x[4 * i], x[4 * i + 1]); o.y = pk2(x[4 * i + 2], x[4 * i + 3]); *(GAS v2u*)(dst + (i & 3) * 256 + (i >> 2) * 8) = o; } }
      else { LAS unsigned char* nw = L + PL_KB + (32 * a) * KBP + cc * 2;
#pragma unroll
          for (int i = 0; i < 32; ++i) *(LAS bf16*)(nw + i * KBP) = (bf16)(pk2(-x[i], 0.f) & 0xffffu); } }
    { const int t = tid >> 3, ks = (tid & 7) * 16, a = t >> 5, tl = t & 31; const float eg = __expf(gam[t]); const LAS float* q = Qs + t * KP + ks; unsigned char* dst = blob + a * DB_IMG + DB_QG + frag_off(tl, ks, 4);
#pragma unroll
      for (int i = 0; i < 4; ++i) { v2u o; o.x = pk2(q[4 * i] * eg, q[4 * i + 1] * eg); o.y = pk2(q[4 * i + 2] * eg, q[4 * i + 3] * eg); *(GAS v2u*)(dst + frag_off(0, 4 * i, 4)) = o; } }
    { const int a = tid >> 8, k = (tid >> 1) & 127, ts = (tid & 1) * 16; const float gl = gam[32 * a + 31]; unsigned char* dst = blob + a * DB_IMG + DB_KDT + frag_off(k, ts, 1);
#pragma unroll
      for (int i = 0; i < 4; ++i) { float e[4];
#pragma unroll
          for (int j = 0; j < 4; ++j) { const int t = 32 * a + ts + 4 * i + j; e[j] = Ks[t * KP + k] * __expf(gl - gam[t]); }
          v2u o; o.x = pk2(e[0], e[1]); o.y = pk2(e[2], e[3]); *(GAS v2u*)(dst + i * 256) = o; } }
    { const int t = tid >> 3, ts = (tid & 7) * 4, a = t >> 5, tl = t & 31; const LAS float* sq = QKs + a * 1024 + tl * 32 + ts;
      v2u o; o.x = pk2(sq[0], sq[1]); o.y = pk2(sq[2], sq[3]); *(GAS v2u*)(blob + a * DB_IMG + DB_QKD + frag_off(tl, ts, 1)) = o; }
    if (tid < 2) *(GAS float*)(blob + tid * DB_IMG + DB_SC) = __expf(gam[32 * tid + 31]);
    __syncthreads();
    { const int ih = F.wave >> 2, ks = F.wave & 3, g = lane >> 4, il = lane & 15;
#pragma unroll
      for (int a = 0; a < 2; ++a) { const LAS unsigned char* src = L + PL_KB + (32 * a + 16 * ih + il) * KBP + (32 * ks + 4 * g) * 2;
          const v2u lo = *(const LAS v2u*)src, hi = *(const LAS v2u*)(src + 32);
          *(GAS v4u*)(blob + a * DB_IMG + DB_NEGWK + F.wave * 1024 + lane * 16) = (v4u){lo.x, lo.y, hi.x, hi.y}; } }
    __syncthreads();
}

constexpr int CH_NBUF = 4, CH_END = CH_NBUF * DB_IMG;
static_assert(CH_END <= MISC_OFF - 1024, "chain LDS");
__device__ __forceinline__ bf16x8 pack_acc2(const f32x4 a, const f32x4 b) { v4u w; w.x = pk2(a[0], a[1]); w.y = pk2(a[2], a[3]); w.z = pk2(b[0], b[1]); w.w = pk2(b[2], b[3]); return __builtin_bit_cast(bf16x8, w); }
#define MFMA16(a, b, c) __builtin_amdgcn_mfma_f32_16x16x32_bf16((a), (b), (c), 0, 0, 0)

__device__ __forceinline__ void dn_chain_unit(Frame& F, int l, int unit) {
    const int b = unit >> 3, h = unit & 7, lane = F.lane, w = F.wave, g = lane >> 4, r = lane & 15;
    const unsigned char* blob0 = F.ws + WS_DNP + (size_t)((b * NH + h) * 64) * DB_IMG;
    float* ORAW = (float*)(F.ws + WS_QN);
    LAS unsigned char* L = lds_opaque(F);
    f32x4 S[8], o[2];
#pragma unroll
    for (int i = 0; i < 8; ++i) S[i] = (f32x4){0.f, 0.f, 0.f, 0.f};
    o[0] = (f32x4){0.f, 0.f, 0.f, 0.f}; o[1] = o[0];
#define CH_DMA(cidx) do { const unsigned char* src_ = blob0 + (size_t)(cidx) * DB_IMG; const int bo_ = ((cidx) & (CH_NBUF - 1)) * DB_IMG; \
        _Pragma("unroll") for (int i_ = 0; i_ < 5; ++i_) { const int pc_ = (w + 8 * i_) < 35 ? (w + 8 * i_) : (w + 8 * i_) - 35; \
            __builtin_amdgcn_global_load_lds((const GAS unsigned*)(src_ + pc_ * 1024 + lane * 16), (LAS unsigned*)(F.lds + bo_ + pc_ * 1024), 16, 0, 0); } } while (0)
#define CH_STORE(cidx) do { float* op_ = ORAW + (size_t)(b * T + (cidx) * 32 + 4 * g) * LW + h * 128 + 16 * w + r; \
        _Pragma("unroll") for (int tb = 0; tb < 2; ++tb) _Pragma("unroll") for (int q = 0; q < 4; ++q) op_[(size_t)(16 * tb + q) * LW] = o[tb][q]; } while (0)
    CH_DMA(0); CH_DMA(1); CH_STORE(0); CH_DMA(2); CH_STORE(0);
    for (int c = 0; c < 64; ++c) {
        const LAS unsigned char* buf = L + (c & (CH_NBUF - 1)) * DB_IMG;
        asm volatile("s_waitcnt vmcnt(26)" ::: "memory");
        __builtin_amdgcn_s_barrier(); asm volatile("" ::: "memory");
        { const int c3 = c + 3 < 64 ? c + 3 : 63; CH_DMA(c3); }
        CH_STORE(c > 0 ? c - 1 : 0);
        const bf16x8 uf = *(const LAS bf16x8*)(buf + DB_UT + w * 1024 + lane * 16); const float gl = *(const LAS float*)(buf + DB_SC);
        bf16x8 Sf[4];
#pragma unroll
        for (int s = 0; s < 4; ++s) Sf[s] = pack_acc2(S[2 * s], S[2 * s + 1]);
        bf16x8 A0[8], A1[8];
#define CH_LD1(A_, sp_) do { _Pragma("unroll") for (int s2 = 0; s2 < 2; ++s2) _Pragma("unroll") for (int tb = 0; tb < 2; ++tb) { \
            A_[4 * s2 + 2 * tb] = *(const LAS bf16x8*)(buf + DB_NEGWK + (tb * 4 + 2 * (sp_) + s2) * 1024 + lane * 16); A_[4 * s2 + 2 * tb + 1] = *(const LAS bf16x8*)(buf + DB_QG + (tb * 4 + 2 * (sp_) + s2) * 1024 + lane * 16); } } while (0)
#define CH_MM1(A_, sp_) do { _Pragma("unroll") for (int s2 = 0; s2 < 2; ++s2) _Pragma("unroll") for (int tb = 0; tb < 2; ++tb) { \
            wa[tb] = MFMA16(A_[4 * s2 + 2 * tb], Sf[2 * (sp_) + s2], wa[tb]); o[tb] = MFMA16(A_[4 * s2 + 2 * tb + 1], Sf[2 * (sp_) + s2], o[tb]); } } while (0)
#define CH_SB() __builtin_amdgcn_sched_barrier(0)
        CH_LD1(A0, 0); CH_LD1(A1, 1); CH_SB();
        f32x4 wa[2];
        { const v4u uw = __builtin_bit_cast(v4u, uf); wa[0] = (f32x4){bflo(uw.x), bfhi(uw.x), bflo(uw.y), bfhi(uw.y)}; wa[1] = (f32x4){bflo(uw.z), bfhi(uw.z), bflo(uw.w), bfhi(uw.w)}; }
        o[0] = (f32x4){0.f, 0.f, 0.f, 0.f}; o[1] = o[0];
        CH_MM1(A0, 0); CH_SB();
#pragma unroll
        for (int kb = 0; kb < 8; ++kb) A0[kb] = *(const LAS bf16x8*)(buf + DB_KDT + kb * 1024 + lane * 16);
        CH_SB();
        CH_MM1(A1, 1); CH_SB();
        A1[0] = *(const LAS bf16x8*)(buf + DB_QKD + lane * 16); A1[1] = *(const LAS bf16x8*)(buf + DB_QKD + 1024 + lane * 16);
        const bf16x8 Wf = pack_acc2(wa[0], wa[1]);
#pragma unroll
        for (int kb = 0; kb < 8; ++kb) S[kb] = S[kb] * gl;
        CH_SB();
#pragma unroll
        for (int kb = 0; kb < 8; ++kb) S[kb] = MFMA16(A0[kb], Wf, S[kb]);
        o[0] = MFMA16(A1[0], Wf, o[0]); o[1] = MFMA16(A1[1], Wf, o[1]);
#undef CH_LD1
#undef CH_MM1
#undef CH_SB
    }
    CH_STORE(63);
    { float* so = F.out + O_PDS + (((size_t)l * NB + b) * NH + h) * HD * HD;
#pragma unroll
      for (int kb = 0; kb < 8; ++kb)
#pragma unroll
          for (int q = 0; q < 4; ++q) so[(size_t)(16 * kb + 4 * g + q) * HD + 16 * w + r] = S[kb][q]; }
    VM_WAIT(); __syncthreads();
#undef CH_DMA
#undef CH_STORE
}
__device__ __forceinline__ void dn_post_rows(Frame& F, int l) {
    const float* ORAW = (const float*)(F.ws + WS_QN); const bf16* P = (const bf16*)(F.ws + WS_P); bf16* OD = (bf16*)(F.ws + WS_OD);
    const int g = F.lane >> 4, r = F.lane & 15;
    const GAS f32x4* nwp = (const GAS f32x4*)(FIN(F, I_DNW) + l * HD + 8 * r); const f32x4 n0 = nwp[0], n1 = nwp[1];
    const int step = F.G * NWAVES * 4;
    for (int it0 = (F.bx * NWAVES + F.wave) * 4 + g; it0 < MP * NH; it0 += 4 * step) {
        f32x4 a[4], b2[4]; v4u zw[4];
#pragma unroll
        for (int q = 0; q < 4; ++q) { const int it = it0 + q * step < MP * NH ? it0 + q * step : it0; const int row = it >> 3, h = it & 7; const size_t off = (size_t)row * LW + h * 128 + 8 * r;
            a[q] = *(const GAS f32x4*)(ORAW + off); b2[q] = *(const GAS f32x4*)(ORAW + off + 4); zw[q] = *(const GAS v4u*)(P + (size_t)row * PW + C_Z + h * 128 + 8 * r); }
#pragma unroll
        for (int q = 0; q < 4; ++q) { const int it = it0 + q * step; if (it < MP * NH) { const int row = it >> 3, h = it & 7; const size_t off = (size_t)row * LW + h * 128 + 8 * r;
            float ss = (a[q][0] * a[q][0] + a[q][1] * a[q][1]) + (a[q][2] * a[q][2] + a[q][3] * a[q][3]) + (b2[q][0] * b2[q][0] + b2[q][1] * b2[q][1]) + (b2[q][2] * b2[q][2] + b2[q][3] * b2[q][3]);
            ss += __shfl_xor(ss, 1); ss += __shfl_xor(ss, 2); ss += __shfl_xor(ss, 4); ss += __shfl_xor(ss, 8);
            const float rstd = __builtin_amdgcn_rsqf(ss * (1.0f / 128.0f) + EPS);
            v4u o; o.x = pk2(a[q][0] * rstd * n0[0] * siluf(bflo(zw[q].x)), a[q][1] * rstd * n0[1] * siluf(bfhi(zw[q].x))); o.y = pk2(a[q][2] * rstd * n0[2] * siluf(bflo(zw[q].y)), a[q][3] * rstd * n0[3] * siluf(bfhi(zw[q].y)));
            o.z = pk2(b2[q][0] * rstd * n1[0] * siluf(bflo(zw[q].z)), b2[q][1] * rstd * n1[1] * siluf(bfhi(zw[q].z))); o.w = pk2(b2[q][2] * rstd * n1[2] * siluf(bflo(zw[q].w)), b2[q][3] * rstd * n1[3] * siluf(bfhi(zw[q].w)));
            *(GAS v4u*)(OD + off) = o; } }
    }
}

constexpr int PH_PER_LAYER = 9;
constexpr int DN_LONG = NB * NH;

#ifdef PROBE_SEL0
#define PROBE_STAMP(tid_) do { if (F.bx == 0 && (tid_) == 0) { volatile LAS unsigned* st_ = (volatile LAS unsigned*)(F.lds + MISC_OFF - 1024); const unsigned n_ = st_[255]; st_[n_] = (unsigned)__builtin_amdgcn_s_memrealtime(); st_[255] = n_ + 1; } } while (0)
#define PROBE_MARK(idx_, tid_) do { if (F.bx == 0 && (tid_) == 0) { volatile LAS unsigned* st_ = (volatile LAS unsigned*)(F.lds + MISC_OFF - 1024); st_[idx_] = (unsigned)__builtin_amdgcn_s_memrealtime(); } } while (0)
#define PROBE_GMARK(c_, l_, k_, Fp_) do { if ((c_) == 0 && (Fp_).tid == 0) __hip_atomic_store((Fp_).ctl + 32768 + (l_) * 8 + (k_), (unsigned)__builtin_amdgcn_s_memrealtime(), RLX_AGENT); } while (0)
#ifdef PROBE_TAIL
#define PROBE_WMARK(t_, l_, k_, Fp_) do { if ((t_) == PROBE_TAIL) PROBE_GMARK((Fp_).bx, l_, k_, Fp_); } while (0)
#define PROBE_TMARK(t_, l_, k_, Fp_) do { if ((t_) == PROBE_TAIL) PROBE_GMARK((Fp_).bx - ((Fp_).G - 1), l_, k_, Fp_); } while (0)
#else
#define PROBE_TMARK(t_, l_, k_, Fp_) do { } while (0)
#define PROBE_WMARK(t_, l_, k_, Fp_) do { } while (0)
#endif
#else
#define PROBE_TMARK(t_, l_, k_, Fp_) do { } while (0)
#define PROBE_WMARK(t_, l_, k_, Fp_) do { } while (0)
#define PROBE_STAMP(tid_) do { } while (0)
#define PROBE_MARK(idx_, tid_) do { } while (0)
#define PROBE_GMARK(c_, l_, k_, Fp_) do { } while (0)
#endif
#define GRID_BAR() do { if (fused) { XcdBarrier b2_ = bar; unsigned long long bp_ = (unsigned long long)bar.bar; int wv_ = F.wave, ln_; asm volatile("v_mbcnt_lo_u32_b32 %0, -1, 0\n\tv_mbcnt_hi_u32_b32 %0, -1, %0" : "=v"(ln_)); asm volatile("" : "+s"(bp_), "+s"(b2_.x), "+s"(wv_)); b2_.bar = (unsigned*)(GAS unsigned*)bp_; xcd_barrier(b2_, wv_ * 64 + ln_); PROBE_STAMP(wv_ * 64 + ln_); } } while (0)
#define IN(k) (lo <= (k) && (k) < hi)
#define STR2(x) #x
#define STR(x) STR2(x)
#define ENTER() Frame Fp = F; asm volatile("; PHASE_SITE line " STR(__LINE__)); asm volatile("v_mbcnt_lo_u32_b32 %0, -1, 0\n\tv_mbcnt_hi_u32_b32 %0, -1, %0" : "=v"(Fp.lane)); \
    { unsigned long long ws_ = (unsigned long long)F.ws, out_ = (unsigned long long)F.out; asm volatile("" : "+s"(ws_), "+s"(out_), "+s"(Fp.bx), "+s"(Fp.G), "+s"(Fp.wave)); \
      Fp.ws = (unsigned char*)(GAS unsigned char*)ws_; Fp.out = (float*)(GAS float*)out_; } \
    Fp.tid = Fp.wave * 64 + Fp.lane; Fp.ctl = (gu32*)(GAS unsigned char*)(Fp.ws + WS_CTL)
#define WL(Fp, l) ((const bf16*)((Fp).ws + WS_W) + (size_t)(l) * WL_ELEMS)

template <int l> __device__ __forceinline__ void layer_phases(const Frame& F, const XcdBarrier& bar, const bool fused, const int lo, const int hi) {
        if (IN(0)) { ENTER(); rms_rows_bf16(Fp, (float*)(Fp.ws + WS_X), FIN(Fp, I_NMIX) + (size_t)l * D, (bf16*)(Fp.ws + WS_XN), l > 0 ? (const bf16*)(Fp.ws + WS_MGF) : nullptr, NSLAB, l == 0 ? FIN(Fp, I_XP) : nullptr, l == 0 ? FIN(Fp, I_XS) : nullptr); GRID_BAR(); }
        if (IN(1)) {
            ENTER();
            pg8::Gemm g{(const bf16*)(Fp.ws + WS_XN), WL(Fp, l) + WL_IN, M, NINP, D, D, D}; pg8::StaticOrder S; S.init(M, NINP, Fp.G, Fp.bx);
            pg8::EpiInProj E{(bf16*)(Fp.ws + WS_P), (float*)(Fp.ws + WS_BA), PW, PW / 256};
            pg8::gemm_phase<pg8::EpiInProj, pg8::StaticOrder, true, true>(Fp.lds + RING_OFF, g, S, E, Fp.tid);
            { ENTER(); PROBE_TMARK(1, l, 5, Fp); p0_tail<1>(Fp, l, R_T1B, R_T1E, static_c0((M / 256) * (NINP / 256), Fp.G)); PROBE_TMARK(1, l, 6, Fp); }
            GRID_BAR();
        }
        if (IN(2)) {
            ENTER();
            for (int u = Fp.bx; u < NB * NH * 32; u += Fp.G) dn_prep_unit(Fp, l, u);
            GRID_BAR();
        }
        if (IN(3)) {
            { ENTER();
              const int c = Fp.bx - DN_LONG, Gr = Fp.G - DN_LONG;
              if (c < 0) { dn_chain_unit(Fp, l, Fp.bx); PROBE_MARK(200 + l, Fp.tid); }
              else { Frame Fq = Fp; Fq.bx = c; Fq.G = Gr;
                     PROBE_GMARK(c, l, 0, Fp);
                     lru_phase2(Fq, l);
                     PROBE_GMARK(c, l, 1, Fp);
                     pool_d_rows(Fq, l);
                     PROBE_GMARK(c, l, 2, Fp);
                     state_outputs(Fq, l);
                     PROBE_GMARK(c, l, 3, Fp);
                     { SmpIn cur, nxt;
                       if (c < SB * NH) dn_sample_load(Fp, l, c, cur);
                       for (int u = c; u < SB * NH; u += Gr) { const int un = u + Gr; if (un < SB * NH) dn_sample_load(Fp, l, un, nxt); dn_sample_unit(Fp, l, u, cur); cur = nxt; } }
                     PROBE_GMARK(c, l, 4, Fp); }
            }
            GRID_BAR();
            { ENTER(); dn_post_rows(Fp, l); PROBE_MARK(230 + l, Fp.tid); for (int u = Fp.bx, k = 0; u < NB * 32 * 8; u += Fp.G, ++k) lru_fix_unit(Fp, l, u, k & 1); PROBE_MARK(240 + l, Fp.tid); }
            { ENTER();
              int kp = 256; asm volatile("" : "+s"(kp));
              pg8::Gemm g{(const bf16*)(Fp.ws + WS_PD), WL(Fp, l) + WL_POOL, 4 * M, 256, kp, 256, 256};
              pg8::GroupedOrder S; S.init(4 * M, 256, Fp.G, Fp.bx); S.tpg = M / 256; S.bgb = (size_t)256 * 256 * 2;
              pg8::EpiPool E{(bf16*)(Fp.ws + WS_OP), FIN(Fp, I_PSC) + (size_t)l * PLW, LW, M / 256};
              pg8::gemm_phase<pg8::EpiPool, pg8::GroupedOrder, true, true>(Fp.lds + RING_OFF, g, S, E, Fp.tid);
            }
            GRID_BAR();
        }
        if (IN(4)) {
            { ENTER(); pg8::BranchOrder S; S.init(MP, D, Fp.G, Fp.bx); S.nbr = 3; S.astride = (size_t)M * LW * 2; S.bstride = (size_t)D * LW * 2;
              pg8::Gemm g{(const bf16*)(Fp.ws + WS_OL), WL(Fp, l) + WL_BR, MP, D, LW, LW, LW}; pg8::EpiBranchAcc E{(const bf16*)(Fp.ws + WS_P) + C_GLRU, PW, (bf16*)(Fp.ws + WS_MG), D};
              pg8::gemm_phase<pg8::EpiBranchAcc, pg8::BranchOrder, true, true>(Fp.lds + RING_OFF, g, S, E, Fp.tid); }
            { ENTER();
              pg8::Gemm g{(const bf16*)(Fp.ws + WS_OL) + (size_t)MP * LW, WL(Fp, l) + WL_BR, MS, D, LW, LW, LW};
              pg8::SliceOrder S; S.init(MS / 256, D / 256, 3, (size_t)M * LW * 2, (size_t)D * LW * 2, 3, Fp.bx);
              pg8::EpiBranchS E{(const bf16*)(Fp.ws + WS_P) + (size_t)MP * PW + C_GLRU, PW, (bf16*)(Fp.ws + WS_MGS), 3 * D};
              PROBE_WMARK(4, l, 5, Fp); pg8::gemm_phase<pg8::EpiBranchS, pg8::SliceOrder, true, true>(Fp.lds + RING_OFF, g, S, E, Fp.tid); PROBE_WMARK(4, l, 6, Fp); }
            { ENTER(); PROBE_TMARK(2, l, 5, Fp); p0_tail<2>(Fp, l, 0, 0, (MS / 256) * (D / 256) * 3); PROBE_TMARK(2, l, 6, Fp); }
            GRID_BAR();
        }
        if (IN(5)) {
            { ENTER();
              pg8::Gemm g{(const bf16*)(Fp.ws + WS_MG), WL(Fp, l) + WL_OUT, MP, D, D, D, D}; pg8::StaticOrder S; S.init(MP, D, Fp.G, Fp.bx);
              pg8::EpiResid E{(float*)(Fp.ws + WS_X), D};
              pg8::gemm_phase<pg8::EpiResid, pg8::StaticOrder, true, true>(Fp.lds + RING_OFF, g, S, E, Fp.tid); }
            { ENTER();
              pg8::Gemm g{(const bf16*)(Fp.ws + WS_MGS), WL(Fp, l) + WL_OUT, MS, D, 1024, 3 * D, D};
              pg8::SliceOrder S; S.init(MS / 256, D / 256, NSLAB_OUT, (size_t)1024 * 2, (size_t)1024 * 2, 2, Fp.bx);
              pg8::EpiSlab E{(bf16*)(Fp.ws + WS_MGF), D, (size_t)MS * D};
              pg8::gemm_phase<pg8::EpiSlab, pg8::SliceOrder, true, true>(Fp.lds + RING_OFF, g, S, E, Fp.tid); }
            GRID_BAR();
        }
        if (IN(6)) { ENTER(); rms_rows_bf16(Fp, (float*)(Fp.ws + WS_X), FIN(Fp, I_NMLP) + (size_t)l * D, (bf16*)(Fp.ws + WS_XN), (const bf16*)(Fp.ws + WS_MGF), NSLAB_OUT); GRID_BAR(); }
        if (IN(7)) {
            ENTER();
            pg8::Gemm g{(const bf16*)(Fp.ws + WS_XN), WL(Fp, l) + WL_UP, M, FF, D, D, D}; pg8::StaticOrder S; S.init(M, FF, Fp.G, Fp.bx);
            pg8::EpiUp E{(bf16*)(Fp.ws + WS_HM), FF};
            pg8::gemm_phase<pg8::EpiUp, pg8::StaticOrder, true, true>(Fp.lds + RING_OFF, g, S, E, Fp.tid);
            { ENTER(); PROBE_TMARK(3, l, 5, Fp); p0_tail<1>(Fp, l, R_T2B, R_T2E, static_c0((M / 256) * (FF / 256), Fp.G)); PROBE_TMARK(3, l, 6, Fp); }
            GRID_BAR();
        }
        if (IN(8)) {
            { ENTER();
              pg8::Gemm g{(const bf16*)(Fp.ws + WS_HM), WL(Fp, l) + WL_DN, MP, D, FF, FF, FF}; pg8::StaticOrder S; S.init(MP, D, Fp.G, Fp.bx);
              pg8::EpiResid E{(float*)(Fp.ws + WS_X), D};
              pg8::gemm_phase<pg8::EpiResid, pg8::StaticOrder, true, true>(Fp.lds + RING_OFF, g, S, E, Fp.tid); }
            { ENTER();
              pg8::Gemm g{(const bf16*)(Fp.ws + WS_HM) + (size_t)MP * FF, WL(Fp, l) + WL_DN, MS, D, FF / NSLAB, FF, FF}; pg8::SliceOrder S; S.init(MS / 256, D / 256, NSLAB, (size_t)(FF / NSLAB) * 2, (size_t)(FF / NSLAB) * 2, NSLAB, Fp.bx);
              pg8::EpiSlab E{(bf16*)(Fp.ws + WS_MGF), D, (size_t)MS * D};
              pg8::gemm_phase<pg8::EpiSlab, pg8::SliceOrder, true, true>(Fp.lds + RING_OFF, g, S, E, Fp.tid); }
            GRID_BAR();
        }
}

__global__ void __launch_bounds__(NTHREADS, 2) fwd(Args args) {
    extern __shared__ __attribute__((aligned(16))) unsigned char lds[];
    Frame F;
    F.lds = (LAS unsigned char*)lds;
    F.MISC = (volatile LAS unsigned*)(F.lds + MISC_OFF);
    F.tid = 0; F.lane = 0; F.wave = __builtin_amdgcn_readfirstlane((int)(threadIdx.x >> 6));
    F.G = gridDim.x; F.bx = blockIdx.x;
    F.ka = (const AS4 Args*)__builtin_amdgcn_kernarg_segment_ptr(); F.out = (float*)(GAS float*)args.out; F.ws = (unsigned char*)(GAS unsigned char*)args.ws;
    F.ctl = (gu32*)(GAS unsigned char*)(args.ws + WS_CTL);
    if (threadIdx.x < 64) ((LAS unsigned*)(F.lds + MISC_OFF))[threadIdx.x] = 0u;
#ifdef PROBE_SEL0
    if (threadIdx.x == 0) ((LAS unsigned*)(F.lds + MISC_OFF - 1024))[255] = 0u;
#endif
    __syncthreads();
    const bool fused = (args.flags & 4) != 0;
    XcdBarrier bar; bar.bar = (unsigned*)(F.ctl + CW_BAR); bar.x = 0; bar.st = nullptr;
    if (fused) bar = xcd_barrier_post((unsigned*)(F.ctl + CW_BAR), F.MISC + 8, (int)threadIdx.x);
    const int lo = args.ph_lo, hi = args.ph_hi;

    PROBE_MARK(250, (int)threadIdx.x);
    if (args.flags & 1) { ENTER(); P0Job J; J.l = 0; J.rb = 0; J.re = 0; J.cc = Fp.bx; J.Gn = Fp.G; p0_convert<0>(Fp, J); }

    if (args.l_lo <= 0 && 0 < args.l_hi) layer_phases<0>(F, bar, fused, lo, hi);
    if (args.l_lo <= 1 && 1 < args.l_hi) layer_phases<1>(F, bar, fused, lo, hi);
    if (args.l_lo <= 2 && 2 < args.l_hi) layer_phases<2>(F, bar, fused, lo, hi);
    if (args.l_lo <= 3 && 3 < args.l_hi) layer_phases<3>(F, bar, fused, lo, hi);
#ifdef PROBE_SEL0
    if (fused && F.bx == 0 && threadIdx.x == 0) {
        volatile LAS unsigned* st_ = (volatile LAS unsigned*)(F.lds + MISC_OFF - 1024); unsigned tot0 = 0, tot1 = 0;
        for (int l = 0; l < DEPTH; ++l) {
#ifdef PROBE_3B
            tot0 += st_[230 + l] - st_[10 * l + 4]; tot1 += (st_[240 + l] - st_[230 + l]) - (st_[1 + 10 * l + PROBE_SEL1] - st_[10 * l + PROBE_SEL1]);
#elif defined(PROBE_P0)
            if (l == 0) tot0 += st_[0] - st_[250];
#elif defined(PROBE_G0)
            tot0 += __hip_atomic_load(F.ctl + 32768 + l * 8 + PROBE_G0 + 1, RLX_AGENT) - __hip_atomic_load(F.ctl + 32768 + l * 8 + PROBE_G0, RLX_AGENT);
            tot1 += __hip_atomic_load(F.ctl + 32768 + l * 8 + PROBE_G1 + 1, RLX_AGENT) - __hip_atomic_load(F.ctl + 32768 + l * 8 + PROBE_G1, RLX_AGENT) - (st_[1 + 10 * l + PROBE_SEL1] - st_[10 * l + PROBE_SEL1]);
#elif defined(PROBE_CHAINWAIT)
            tot0 += st_[210 + l]; tot1 += st_[220 + l] - (st_[1 + 10 * l + PROBE_SEL1] - st_[10 * l + PROBE_SEL1]);
#elif defined(PROBE_CHAIN)
            tot0 += st_[200 + l] - st_[10 * l + 3];
#else
            tot0 += st_[1 + 10 * l + PROBE_SEL0] - st_[10 * l + PROBE_SEL0];
#endif
            tot1 += st_[1 + 10 * l + PROBE_SEL1] - st_[10 * l + PROBE_SEL1]; }
        unsigned d0 = tot0 / (100u * PROBE_UNIT), d1 = tot1 / (100u * PROBE_UNIT); d0 = d0 > 99u ? 99u : d0; d1 = d1 > 99u ? 99u : d1;
        const unsigned long long t0 = __builtin_amdgcn_s_memrealtime(), ticks = PROBE_Q0 * 100ull * d0 + PROBE_Q1 * 100ull * d1;
        while (__builtin_amdgcn_s_memrealtime() - t0 < ticks) __builtin_amdgcn_s_sleep(20);
    }
#endif
    if (args.flags & 2) { ENTER(); rms_rows_f32(Fp, (const float*)(Fp.ws + WS_X), FIN(Fp, I_NFIN), Fp.out + O_YP, (const bf16*)(Fp.ws + WS_MGF)); }
}

#ifndef MK_FUSED
#define MK_FUSED 1
#endif
extern "C" void kernel_launch(void* const* d_in, const int* in_sizes, int n_in, void* d_out, int out_size, void* d_ws, size_t ws_size, hipStream_t stream) {
    static int grid = 0;
    if (grid == 0) {
        if (n_in != N_INPUTS || (size_t)out_size != O_END || ws_size < WS_END) { fprintf(stderr, "kernel_launch: unexpected shapes: n_in %d out %d ws %zu (need %zu)\n", n_in, out_size, ws_size, (size_t)WS_END); grid = -1; return; }
        int dev = 0, cus = 0, per_cu = 0;
        if (hipGetDevice(&dev) != hipSuccess || hipDeviceGetAttribute(&cus, hipDeviceAttributeMultiprocessorCount, dev) != hipSuccess) { grid = -1; return; }
        if (hipFuncSetAttribute((const void*)fwd, hipFuncAttributeMaxDynamicSharedMemorySize, LDS_BYTES) != hipSuccess) { fprintf(stderr, "kernel_launch: hipFuncSetAttribute failed\n"); grid = -1; return; }
        if (hipOccupancyMaxActiveBlocksPerMultiprocessor(&per_cu, (const void*)fwd, NTHREADS, LDS_BYTES) != hipSuccess || per_cu < 1) fprintf(stderr, "kernel_launch: occupancy query says %d\n", per_cu);
        (void)hipGetLastError();
        grid = cus;
        if (cus != 256) fprintf(stderr, "kernel_launch: built for a 256-CU device (work splits assume 256 workgroups); found %d\n", cus);
    }
    if (grid < 0) return;
    (void)hipMemsetAsync((char*)d_ws + WS_CTL, 0, CTL_ZERO_BYTES, stream);
    Args a{};
    for (int i = 0; i < N_INPUTS; ++i) a.in[i] = (const float*)d_in[i];
    a.out = (float*)d_out; a.ws = (unsigned char*)d_ws;
#define LAUNCH(L0, L1, P0_, P1_, FL) do { a.l_lo = (L0); a.l_hi = (L1); a.ph_lo = (P0_); a.ph_hi = (P1_); a.flags = (FL); hipLaunchKernelGGL(fwd, dim3(grid), dim3(NTHREADS), LDS_BYTES, stream, a); } while (0)
#if MK_FUSED
    LAUNCH(0, DEPTH, 0, PH_PER_LAYER, 1 | 2 | 4);
#else
    LAUNCH(0, 0, 0, 0, 1);
    for (int l = 0; l < DEPTH; ++l)
        for (int p = 0; p < PH_PER_LAYER; ++p) LAUNCH(l, l + 1, p, p + 1, 0);
    LAUNCH(0, 0, 0, 0, 2);
#endif
#undef LAUNCH
}
```
